# Optimizing an MI355X kernel written in HIP

```python
import jax, jax.numpy as jnp
from jax import lax
import numpy as np


D_MODEL = 1024
BATCH = 4
SEQ = 8192
DEPTH = 4

HEAD_DIM = 64
ROPE_THETA = 10000.0
EPS = 1e-6
NEG = -1e30
TINY = 1e-30
FORCE_SCORE = 1e9

DIL_PAIRS = ((128, 1), (512, 4), (2048, 16))
N_DIL = 3
A_HEADS_PER_GROUP = 8
A_HEADS = N_DIL * A_HEADS_PER_GROUP
A_BLOCK = 128
A_OUT = A_HEADS_PER_GROUP * HEAD_DIM

B_Q_HEADS = 8
B_KV_HEADS = 2
B_GQA = B_Q_HEADS // B_KV_HEADS
CMP_LEN = 32
CMP_STRIDE = 16
CMP_HIDDEN = 256
SEL_LEN = 64
N_SELECT = 16
WIN = 512
B_BLOCK = 128
B_OUT = B_Q_HEADS * HEAD_DIM

D_FF = 2816
CONV_W = 3

A_QKV = 3 * A_HEADS * HEAD_DIM
B_QD = B_Q_HEADS * HEAD_DIM
B_KV = 3 * 2 * B_KV_HEADS * HEAD_DIM
B_GATE = 3 * B_Q_HEADS
MERGE = 2 * D_MODEL
N_IN = A_QKV + B_QD + B_KV + B_GATE + MERGE
IN_SPLITS = (A_QKV, A_QKV + B_QD, A_QKV + B_QD + B_KV, A_QKV + B_QD + B_KV + B_GATE)

kernel_name = 'hybrid_dilated_nsa_convffn'


def rmsnorm(x, g):
    xf = x.astype(jnp.float32)
    y = xf * lax.rsqrt(jnp.mean(xf * xf, axis=-1, keepdims=True) + EPS)
    return (y * g.astype(jnp.float32)).astype(x.dtype)


def rope_tables(pos):
    half = HEAD_DIM // 2
    inv_freq = ROPE_THETA ** (-jnp.arange(half, dtype=jnp.float32) / half)
    ang = pos.astype(jnp.float32)[:, None] * inv_freq[None, :]
    return jnp.cos(ang), jnp.sin(ang)


def apply_rope(x, cos, sin):
    half = HEAD_DIM // 2
    shape = (cos.shape[0],) + (1,) * (x.ndim - 3) + (half,)
    c = cos.reshape(shape).astype(x.dtype)
    s = sin.reshape(shape).astype(x.dtype)
    x1, x2 = x[..., :half], x[..., half:]
    return jnp.concatenate([x1 * c - x2 * s, x2 * c + x1 * s], axis=-1)


def banded_attention(q, k, v, max_dist, block):
    n, L, hk, g, dh = q.shape
    nb = L // block
    n_prev = -(-max_dist // block)
    qb = q.reshape(n, nb, block, hk, g, dh)

    def band(t):
        tb = t.reshape(n, nb, block, hk, dh)
        tp = jnp.pad(tb, ((0, 0), (n_prev, 0), (0, 0), (0, 0), (0, 0)))
        return jnp.concatenate([tp[:, i:i + nb] for i in range(n_prev + 1)], axis=2)

    kb, vb = band(k), band(v)
    s = jnp.einsum('nbqhgd,nbkhd->nbhgqk', qb, kb, preferred_element_type=jnp.float32) * (dh ** -0.5)
    qpos = jnp.arange(nb)[:, None] * block + jnp.arange(block)[None, :]
    kpos = (jnp.arange(nb)[:, None] - n_prev) * block + jnp.arange((n_prev + 1) * block)[None, :]
    dist = qpos[:, :, None] - kpos[:, None, :]
    valid = (dist >= 0) & (dist <= max_dist) & (kpos[:, None, :] >= 0)
    s = jnp.where(valid[None, :, None, None], s, NEG)
    lse = jax.nn.logsumexp(s, axis=-1)
    p = jnp.exp(s - lse[..., None])
    o = jnp.einsum('nbhgqk,nbkhd->nbqhgd', p.astype(v.dtype), vb)
    return o.reshape(n, L, hk, g, dh), lse.transpose(0, 1, 4, 2, 3).reshape(n, L, hk, g)


def dilated_mixer(q, k, v):
    B, S, _, dh = q.shape
    hpg = A_HEADS_PER_GROUP
    outs, lses = [], []
    for gi, (window, dil) in enumerate(DIL_PAIRS):
        hs = slice(gi * hpg, (gi + 1) * hpg)
        L = S // dil
        Lp = -(-L // A_BLOCK) * A_BLOCK

        def to_sub(t):
            t = t.reshape(B, L, dil, hpg, dh).transpose(0, 2, 1, 3, 4).reshape(B * dil, L, hpg, dh)
            return jnp.pad(t, ((0, 0), (0, Lp - L), (0, 0), (0, 0)))

        o, lse = banded_attention(to_sub(q[:, :, hs])[:, :, :, None], to_sub(k[:, :, hs]),
                                  to_sub(v[:, :, hs]), window // dil, A_BLOCK)
        o = o[:, :L, :, 0].reshape(B, dil, L, hpg, dh).transpose(0, 2, 1, 3, 4).reshape(B, S, hpg, dh)
        lse = lse[:, :L, :, 0].reshape(B, dil, L, hpg).transpose(0, 2, 1, 3).reshape(B, S, hpg)
        outs.append(o)
        lses.append(lse)
    wts = jax.nn.softmax(jnp.stack(lses, axis=0), axis=0)
    o = jnp.sum(wts[..., None] * jnp.stack(outs, axis=0).astype(jnp.float32), axis=0)
    return o.astype(q.dtype).reshape(B, S, A_OUT)


def compress(t, pos_emb, w1, w2):
    B, S, H, dh = t.shape
    r = CMP_LEN // CMP_STRIDE
    nc = S // CMP_STRIDE
    n_cmp = nc - r + 1
    ch = t.reshape(B, nc, CMP_STRIDE, H, dh)
    blk = jnp.concatenate([ch[:, i:i + n_cmp] for i in range(r)], axis=2)
    blk = blk + pos_emb[None, None, :, None, :].astype(t.dtype)
    flat = blk.transpose(0, 1, 3, 2, 4).reshape(B, n_cmp, H, CMP_LEN * dh)
    return jax.nn.gelu(flat @ w1) @ w2


def nsa_mixer(q, k_cmp, v_cmp, k_sel, v_sel, k_win, v_win, gate_logits):
    B, S, H, G, dh = q.shape
    scale = dh ** -0.5
    n_cmp = k_cmp.shape[1]
    n_slc = S // SEL_LEN
    n_sel = min(N_SELECT, n_slc)
    r = CMP_LEN // CMP_STRIDE
    nq = S // B_BLOCK
    cmp_end = jnp.arange(n_cmp) * CMP_STRIDE + CMP_LEN - 1
    blk_ids = jnp.arange(n_slc)
    kb_sel = k_sel.reshape(B, n_slc, SEL_LEN, H, dh).transpose(0, 3, 1, 2, 4)
    vb_sel = v_sel.reshape(B, n_slc, SEL_LEN, H, dh).transpose(0, 3, 1, 2, 4)
    b_idx = jnp.arange(B)[:, None, None, None]
    h_idx = jnp.arange(H)[None, None, :, None]
    q_blocks = q.reshape(B, nq, B_BLOCK, H, G, dh).transpose(1, 0, 2, 3, 4, 5)

    def step(args):
        qb, bi = args
        t = bi * B_BLOCK + jnp.arange(B_BLOCK)
        s = jnp.einsum('bqhgd,bchd->bqhgc', qb, k_cmp, preferred_element_type=jnp.float32) * scale
        valid = (cmp_end[None, :] <= t[:, None])[None, :, None, None, :]
        s_m = jnp.where(valid, s, NEG)
        m = jnp.max(s_m, axis=-1, keepdims=True)
        e = jnp.where(valid, jnp.exp(s_m - m), 0.0)
        p = e / jnp.maximum(jnp.sum(e, axis=-1, keepdims=True), TINY)
        o_cmp = jnp.einsum('bqhgc,bchd->bqhgd', p.astype(v_cmp.dtype), v_cmp)
        imp = jnp.sum(p, axis=3)
        chunk = sum(jnp.pad(imp, ((0, 0), (0, 0), (0, 0), (i, r - 1 - i))) for i in range(r))
        p_slc = chunk.reshape(B, B_BLOCK, H, n_slc, SEL_LEN // CMP_STRIDE).sum(-1)
        cur = t // SEL_LEN
        forced = (blk_ids[None] == 0) | (blk_ids[None] == cur[:, None]) | (blk_ids[None] == cur[:, None] - 1)
        causal_blk = blk_ids[None] * SEL_LEN <= t[:, None]
        score = jnp.where(forced[None, :, None], FORCE_SCORE,
                          jnp.where(causal_blk[None, :, None], p_slc, -1.0))
        _, sel = lax.top_k(score, n_sel)
        kg = kb_sel[b_idx, h_idx, sel].reshape(B, B_BLOCK, H, n_sel * SEL_LEN, dh)
        vg = vb_sel[b_idx, h_idx, sel].reshape(B, B_BLOCK, H, n_sel * SEL_LEN, dh)
        kpos = (sel[..., None] * SEL_LEN + jnp.arange(SEL_LEN)).reshape(B, B_BLOCK, H, n_sel * SEL_LEN)
        s2 = jnp.einsum('bqhgd,bqhkd->bqhgk', qb, kg, preferred_element_type=jnp.float32) * scale
        s2 = jnp.where((kpos <= t[None, :, None, None])[:, :, :, None, :], s2, NEG)
        p2 = jax.nn.softmax(s2, axis=-1)
        o_sel = jnp.einsum('bqhgk,bqhkd->bqhgd', p2.astype(vg.dtype), vg)
        return o_cmp, o_sel

    o_cmp, o_sel = lax.map(step, (q_blocks, jnp.arange(nq)))
    o_cmp = o_cmp.transpose(1, 0, 2, 3, 4, 5).reshape(B, S, H, G, dh)
    o_sel = o_sel.transpose(1, 0, 2, 3, 4, 5).reshape(B, S, H, G, dh)
    o_win, _ = banded_attention(q, k_win, v_win, WIN - 1, B_BLOCK)
    g = jax.nn.sigmoid(gate_logits.reshape(B, S, 3, H, G, 1))
    o = g[:, :, 0] * o_cmp + g[:, :, 1] * o_sel + g[:, :, 2] * o_win
    return o.reshape(B, S, B_OUT)


def causal_dwconv(t, w, b):
    S = t.shape[1]
    tp = jnp.pad(t, ((0, 0), (CONV_W - 1, 0), (0, 0)))
    out = b
    for i in range(CONV_W):
        out = out + w[i] * tp[:, i:i + S]
    return out


def setup_inputs(seed: int = 0) -> dict:
    key = jax.random.key(seed)
    ks = jax.random.split(key, 18)

    def nrm(k, shape, fan):
        return jax.random.normal(k, shape, jnp.float32) * fan ** -0.5

    def gain(k, shape):
        return 1.0 + 0.01 * jax.random.normal(k, shape, jnp.float32)

    return {
        'x': jax.random.normal(ks[0], (BATCH, SEQ, D_MODEL), jnp.float32),
        'norm_mix_g': gain(ks[1], (DEPTH, D_MODEL)),
        'w_in': nrm(ks[2], (DEPTH, D_MODEL, N_IN), D_MODEL),
        'a_q_g': gain(ks[3], (DEPTH, HEAD_DIM)),
        'a_k_g': gain(ks[4], (DEPTH, HEAD_DIM)),
        'b_q_g': gain(ks[5], (DEPTH, HEAD_DIM)),
        'b_k_g': gain(ks[6], (DEPTH, 3, HEAD_DIM)),
        'cmp_pos': 0.02 * jax.random.normal(ks[7], (DEPTH, 2, CMP_LEN, HEAD_DIM), jnp.float32),
        'cmp_w1': nrm(ks[8], (DEPTH, 2, CMP_LEN * HEAD_DIM, CMP_HIDDEN), CMP_LEN * HEAD_DIM),
        'cmp_w2': nrm(ks[9], (DEPTH, 2, CMP_HIDDEN, HEAD_DIM), CMP_HIDDEN),
        'w_proj_a': nrm(ks[10], (DEPTH, A_OUT, D_MODEL), A_OUT),
        'w_proj_b': nrm(ks[11], (DEPTH, B_OUT, D_MODEL), B_OUT),
        'w_out': nrm(ks[12], (DEPTH, D_MODEL, D_MODEL), D_MODEL),
        'norm_ffn_g': gain(ks[13], (DEPTH, D_MODEL)),
        'w_up': nrm(ks[14], (DEPTH, D_MODEL, 2 * D_FF), D_MODEL),
        'conv_w': nrm(ks[15], (DEPTH, CONV_W, D_FF), CONV_W),
        'conv_b': 0.01 * jax.random.normal(ks[16], (DEPTH, D_FF), jnp.float32),
        'w_down': nrm(ks[17], (DEPTH, D_FF, D_MODEL), D_FF),
    }


def reference(x, norm_mix_g, w_in, a_q_g, a_k_g, b_q_g, b_k_g, cmp_pos, cmp_w1, cmp_w2,
              w_proj_a, w_proj_b, w_out, norm_ffn_g, w_up, conv_w, conv_b, w_down):
    B, S, _ = x.shape
    cos, sin = rope_tables(jnp.arange(S))
    n_cmp = S // CMP_STRIDE - CMP_LEN // CMP_STRIDE + 1
    cos_c, sin_c = rope_tables(jnp.arange(n_cmp) * CMP_STRIDE + CMP_LEN - 1)
    for l in range(DEPTH):
        h = rmsnorm(x, norm_mix_g[l])
        proj = h @ w_in[l]
        a_qkv, b_q, b_kv, b_gate, merge = jnp.split(proj, IN_SPLITS, axis=-1)
        a_qkv = a_qkv.reshape(B, S, 3, A_HEADS, HEAD_DIM)
        qa = apply_rope(rmsnorm(a_qkv[:, :, 0], a_q_g[l]), cos, sin)
        ka = apply_rope(rmsnorm(a_qkv[:, :, 1], a_k_g[l]), cos, sin)
        out_a = dilated_mixer(qa, ka, a_qkv[:, :, 2])
        qb = apply_rope(rmsnorm(b_q.reshape(B, S, B_KV_HEADS, B_GQA, HEAD_DIM), b_q_g[l]), cos, sin)
        b_kv = b_kv.reshape(B, S, 3, 2, B_KV_HEADS, HEAD_DIM)
        k_cmp = compress(b_kv[:, :, 0, 0], cmp_pos[l, 0], cmp_w1[l, 0], cmp_w2[l, 0])
        k_cmp = apply_rope(rmsnorm(k_cmp, b_k_g[l, 0]), cos_c, sin_c)
        v_cmp = compress(b_kv[:, :, 0, 1], cmp_pos[l, 1], cmp_w1[l, 1], cmp_w2[l, 1])
        k_sel = apply_rope(rmsnorm(b_kv[:, :, 1, 0], b_k_g[l, 1]), cos, sin)
        k_win = apply_rope(rmsnorm(b_kv[:, :, 2, 0], b_k_g[l, 2]), cos, sin)
        out_b = nsa_mixer(qb, k_cmp, v_cmp, k_sel, b_kv[:, :, 1, 1], k_win, b_kv[:, :, 2, 1], b_gate)
        gate = jax.nn.sigmoid(merge.reshape(B, S, 2, D_MODEL))
        mixed = gate[:, :, 0] * (out_a @ w_proj_a[l]) + gate[:, :, 1] * (out_b @ w_proj_b[l])
        x = x + mixed @ w_out[l]
        h = rmsnorm(x, norm_ffn_g[l])
        g_in, u = jnp.split(h @ w_up[l], 2, axis=-1)
        x = x + (jax.nn.silu(causal_dwconv(g_in, conv_w[l], conv_b[l])) * u) @ w_down[l]
    return x
```

```cpp
#include <hip/hip_runtime.h>
#include <hip/hip_cooperative_groups.h>
#include <cstdio>
#include <cstdint>
#include <type_traits>
namespace cg = cooperative_groups;
__device__ __forceinline__ int otid() { int t = threadIdx.x; asm volatile("" : "+v"(t)); return t; }
namespace pg8 {
#define PG8_LAS __attribute__((address_space(3)))
typedef unsigned short bf16_t;
typedef short bf16x8 __attribute__((ext_vector_type(8)));
typedef float f32x4 __attribute__((ext_vector_type(4)));
typedef unsigned u32x4 __attribute__((ext_vector_type(4)));
constexpr int BM = 256, BK = 64, HALF = 128, HTB = HALF * BK * 2  , STAGE_BYTES = 8 * HTB, NXCD = 8, WGM = 8;

__host__ __device__ __forceinline__ int lds_byte(int r, int c) { const int st = (r >> 4) * 2 + (c >> 5), rr = r & 15, cc = c & 31, ob = rr * 64 + cc * 2; return st * 1024 + (ob ^ (((ob >> 9) & 1) << 5)); }
__host__ __device__ __forceinline__ void stage_rc(int b, int& R, int& C) { const int st = b / 1024, sb = b % 1024, swz = sb ^ (((sb >> 9) & 1) << 5); R = (st >> 1) * 16 + swz / 64; C = (st & 1) * 32 + (swz % 64) / 2; }
__host__ __device__ __forceinline__ int perm32(int rho) { const int n = rho >> 4, i = rho & 15; return 8 * (i >> 2) + 4 * n + (i & 3); }

struct Unit { int pm, pn; };
struct Gemm { const bf16_t* A; const bf16_t* Bt; int M, N, K, lda; };

struct StaticOrder {
    int nM, nN, nwg, G, c;
    __host__ __device__ void init(int M, int N, int G_, int c_) { nM = M / BM; nN = N / BM; nwg = nM * nN; G = G_; c = c_; }
    __host__ __device__ bool next(int i, Unit& u) const {
        const long L = (long)i * G + c; if (L >= nwg) return false;
        int wgid = (int)L; { const int q = nwg / NXCD, r = nwg % NXCD, xcd = wgid % NXCD, off = wgid / NXCD; wgid = (xcd < r ? xcd * (q + 1) : r * (q + 1) + (xcd - r) * q) + off; }
        const int nig = WGM * nN, gid = wgid / nig, fm = gid * WGM, gsz = (nM - fm) < WGM ? (nM - fm) : WGM;
        u.pm = fm + ((wgid % nig) % gsz); u.pn = (wgid % nig) / gsz; return true;
    }
    __device__ __forceinline__ void a_ready(const Unit&) const {}
    __device__ __forceinline__ void done(const Unit&) const {}
};

typedef float cvt_f32x2_t __attribute__((ext_vector_type(2))); typedef __bf16 cvt_bf16x2_t __attribute__((ext_vector_type(2)));
__device__ __forceinline__ unsigned cvt_pk_bf16(float lo, float hi) { cvt_f32x2_t v = {lo, hi}; cvt_bf16x2_t b = __builtin_convertvector(v, cvt_bf16x2_t); return __builtin_bit_cast(unsigned, b); }
template <class Epi, class Sched, bool ALIGN_EPI = false, bool SP2 = false>
__device__ __forceinline__ void gemm_phase(PG8_LAS unsigned char* lds, const Gemm g, const Sched& S, const Epi& E) {
    const int tid = otid(), wid = __builtin_amdgcn_readfirstlane(tid >> 6), lane = tid & 63, wr = wid >> 2, wc = wid & 3, fr = lane & 15, fq = lane >> 4;
    const int K = g.K, nt = K / BK;
    unsigned voffA[2], voffB[2];
#pragma unroll
    for (int i = 0; i < 2; ++i) { int R, C; stage_rc(tid * 16 + i * 8192, R, C); const int Rb = Epi::PERM ? ((R & ~31) + perm32(R & 31)) : R;
        voffA[i] = (unsigned)(R * g.lda + C) * 2u; voffB[i] = (unsigned)(Rb * K + C) * 2u; }
    const size_t kstep = (size_t)(BK * 2);
    const size_t hstepB = (size_t)HALF * K * 2, hstepA = (size_t)HALF * g.lda * 2;
    const size_t tstepA = 2 * hstepA, tstepB = 2 * hstepB;
    const unsigned ldsw = (unsigned)wid * 1024u;
    const int aoff = lds_byte(wr * 64 + fr, fq * 8), boff = lds_byte(wc * 32 + fr, fq * 8);
#define PG8_SA(b, h) (((b) * 2 + (h)) * HTB)
#define PG8_SB(b, h) ((4 + (b) * 2 + (h)) * HTB)
#define PG8_STAGE(bufoff, gbase, voff) do { _Pragma("unroll") for (int _i = 0; _i < 2; ++_i) \
        __builtin_amdgcn_global_load_lds((const unsigned*)((const char*)(gbase) + (voff)[_i]), (PG8_LAS unsigned*)(lds + (bufoff) + ldsw + _i * 8192), 16, 0, 0); } while (0)
#define PG8_LDA(dst, b, h) do { _Pragma("unroll") for (int m = 0; m < 4; ++m) _Pragma("unroll") for (int k = 0; k < 2; ++k) dst[m][k] = *(const PG8_LAS bf16x8*)(lds + PG8_SA(b, h) + aoff + m * 2048 + k * 1024); } while (0)
#define PG8_LDB(dst, b, h) do { _Pragma("unroll") for (int n = 0; n < 2; ++n) _Pragma("unroll") for (int k = 0; k < 2; ++k) dst[n][k] = *(const PG8_LAS bf16x8*)(lds + PG8_SB(b, h) + boff + n * 2048 + k * 1024); } while (0)
#define PG8_MMA(ai, bj, At, Bt) do { __builtin_amdgcn_s_setprio(1); _Pragma("unroll") for (int m = 0; m < 4; ++m) _Pragma("unroll") for (int n = 0; n < 2; ++n) _Pragma("unroll") for (int k = 0; k < 2; ++k) \
        acc[ai][bj][m][n] = __builtin_amdgcn_mfma_f32_16x16x32_bf16(Bt[n][k], At[m][k], acc[ai][bj][m][n], 0, 0, 0); __builtin_amdgcn_s_setprio(0); } while (0)
#define PG8_WAIT_V(n) asm volatile("s_waitcnt vmcnt(" #n ")" ::: "memory")
#define PG8_WAIT_L(n) asm volatile("s_waitcnt lgkmcnt(" #n ")" ::: "memory")
#define PG8_BAR __builtin_amdgcn_s_barrier()
#define PG8_SCHED __builtin_amdgcn_sched_barrier(0)
    Unit cur, nxt; int ui = 0;
    if (!S.next(0, cur)) return;
    f32x4 acc[2][2][4][2];
#pragma unroll
    for (int a = 0; a < 2; ++a)
#pragma unroll
        for (int b = 0; b < 2; ++b)
#pragma unroll
            for (int m = 0; m < 4; ++m)
#pragma unroll
                for (int n = 0; n < 2; ++n) acc[a][b][m][n] = (f32x4){0.f, 0.f, 0.f, 0.f};
    bf16x8 At[4][2], B0[2][2], B1[2][2];
    const char* cA = (const char*)g.A + (size_t)cur.pm * tstepA; const char* cB = (const char*)g.Bt + (size_t)cur.pn * tstepB;
    S.a_ready(cur);
    if constexpr (SP2) {
        PG8_STAGE(PG8_SB(0, 0), cB, voffB); PG8_STAGE(PG8_SB(0, 1), cB + hstepB, voffB); PG8_STAGE(PG8_SA(0, 0), cA, voffA); PG8_STAGE(PG8_SA(0, 1), cA + hstepA, voffA);
        if (wr == 1) PG8_BAR;
        PG8_WAIT_V(2); PG8_BAR;
        PG8_STAGE(PG8_SB(1, 0), cB + kstep, voffB); PG8_STAGE(PG8_SA(1, 0), cA + kstep, voffA); PG8_STAGE(PG8_SB(1, 1), cB + hstepB + kstep, voffB);
        PG8_WAIT_V(6); PG8_BAR;
    } else {
        PG8_STAGE(PG8_SB(0, 0), cB, voffB); PG8_STAGE(PG8_SA(0, 0), cA, voffA); PG8_STAGE(PG8_SB(0, 1), cB + hstepB, voffB); PG8_STAGE(PG8_SA(0, 1), cA + hstepA, voffA);
        if (wr == 1) PG8_BAR;
        PG8_WAIT_V(4); PG8_BAR;
        PG8_STAGE(PG8_SB(1, 0), cB + kstep, voffB); PG8_STAGE(PG8_SA(1, 0), cA + kstep, voffA); PG8_STAGE(PG8_SB(1, 1), cB + hstepB + kstep, voffB);
        PG8_WAIT_V(6); PG8_BAR;
    }
    for (;;) {
        const bool has_next = S.next(ui + 1, nxt);
        const char* nA = has_next ? (const char*)g.A + (size_t)nxt.pm * tstepA : cA; const char* nB = has_next ? (const char*)g.Bt + (size_t)nxt.pn * tstepB : cB;
        for (int t = 0; t < nt; t += 2) {
            if constexpr (Epi::HAS_MID) { if (t == (nt >> 1)) E.mid(acc, cur, wr, wc, fr, fq); }
            const bool last = (t == nt - 2);
            const char* a1 = cA + (size_t)(t + 1) * kstep;
            const char* a2 = last ? nA : cA + (size_t)(t + 2) * kstep; const char* b2 = last ? nB : cB + (size_t)(t + 2) * kstep;
            const char* a3 = a2 + kstep; const char* b3 = b2 + kstep;
            if (last && has_next) S.a_ready(nxt);
            if constexpr (SP2) {
            PG8_LDB(B0, 0, 0); PG8_LDB(B1, 0, 1); PG8_SCHED; PG8_LDA(At, 0, 0); PG8_STAGE(PG8_SA(1, 1), a1 + hstepA, voffA);
            PG8_WAIT_V(8); PG8_WAIT_L(0); PG8_BAR; PG8_MMA(0, 0, At, B0); PG8_MMA(0, 1, At, B1); PG8_BAR; PG8_SCHED;
            PG8_LDA(At, 0, 1); PG8_STAGE(PG8_SB(0, 0), b2, voffB); PG8_STAGE(PG8_SB(0, 1), b2 + hstepB, voffB); PG8_STAGE(PG8_SA(0, 0), a2, voffA);
            PG8_WAIT_V(8); PG8_WAIT_L(0); PG8_BAR; PG8_MMA(1, 0, At, B0); PG8_MMA(1, 1, At, B1); PG8_BAR; PG8_SCHED;
            PG8_LDB(B0, 1, 0); PG8_LDB(B1, 1, 1); PG8_SCHED; PG8_LDA(At, 1, 0); PG8_STAGE(PG8_SA(0, 1), a2 + hstepA, voffA);
            PG8_WAIT_V(8); PG8_WAIT_L(0); PG8_BAR; PG8_MMA(0, 0, At, B0); PG8_MMA(0, 1, At, B1); PG8_BAR; PG8_SCHED;
            PG8_LDA(At, 1, 1); PG8_STAGE(PG8_SB(1, 0), b3, voffB); PG8_STAGE(PG8_SB(1, 1), b3 + hstepB, voffB); PG8_STAGE(PG8_SA(1, 0), a3, voffA);
            PG8_WAIT_V(8); PG8_WAIT_L(0); PG8_BAR; PG8_MMA(1, 0, At, B0); PG8_MMA(1, 1, At, B1); PG8_BAR; PG8_SCHED;
            } else {
            PG8_LDB(B0, 0, 0); PG8_SCHED; PG8_LDA(At, 0, 0); PG8_STAGE(PG8_SA(1, 1), a1 + hstepA, voffA);
            PG8_WAIT_L(8); PG8_BAR; PG8_WAIT_L(0); PG8_MMA(0, 0, At, B0); PG8_BAR; PG8_SCHED;
            PG8_LDB(B1, 0, 1); PG8_STAGE(PG8_SB(0, 0), b2, voffB);
            PG8_BAR; PG8_WAIT_L(0); PG8_MMA(0, 1, At, B1); PG8_BAR;
            PG8_LDA(At, 0, 1); PG8_STAGE(PG8_SA(0, 0), a2, voffA);
            PG8_BAR; PG8_WAIT_L(0); PG8_MMA(1, 0, At, B0); PG8_BAR; PG8_SCHED;
            PG8_STAGE(PG8_SB(0, 1), b2 + hstepB, voffB);
            PG8_WAIT_V(6); PG8_BAR; PG8_MMA(1, 1, At, B1); PG8_BAR;
            PG8_LDB(B0, 1, 0); PG8_SCHED; PG8_LDA(At, 1, 0); PG8_STAGE(PG8_SA(0, 1), a2 + hstepA, voffA);
            PG8_WAIT_L(8); PG8_BAR; PG8_WAIT_L(0); PG8_MMA(0, 0, At, B0); PG8_BAR; PG8_SCHED;
            PG8_LDB(B1, 1, 1); PG8_STAGE(PG8_SB(1, 0), b3, voffB);
            PG8_BAR; PG8_WAIT_L(0); PG8_MMA(0, 1, At, B1); PG8_BAR;
            PG8_LDA(At, 1, 1); PG8_STAGE(PG8_SA(1, 0), a3, voffA);
            PG8_BAR; PG8_WAIT_L(0); PG8_MMA(1, 0, At, B0); PG8_BAR; PG8_SCHED;
            PG8_STAGE(PG8_SB(1, 1), b3 + hstepB, voffB);
            PG8_WAIT_V(6); PG8_BAR; PG8_MMA(1, 1, At, B1); PG8_BAR;
            }
        }
        if constexpr (ALIGN_EPI) { if (wr == 0) PG8_BAR; }
        if constexpr (!Epi::AFTER_DRAIN) { E(acc, cur, wr, wc, fr, fq); S.done(cur); }
        if (!has_next) break;
#pragma unroll
        for (int a = 0; a < 2; ++a)
#pragma unroll
            for (int b = 0; b < 2; ++b)
#pragma unroll
                for (int m = 0; m < 4; ++m)
#pragma unroll
                    for (int n = 0; n < 2; ++n) acc[a][b][m][n] = (f32x4){0.f, 0.f, 0.f, 0.f};
        cur = nxt; cA = nA; cB = nB; ++ui;
        if constexpr (ALIGN_EPI) { if (wr == 1) PG8_BAR; }
    }
    PG8_WAIT_V(0);
    if constexpr (!ALIGN_EPI) { if (wr == 0) PG8_BAR; }
    PG8_BAR;
    if constexpr (Epi::AFTER_DRAIN) { E.fused(acc, cur, wr, wc, fr, fq, lds, wid, lane); S.done(cur); }
#undef PG8_SA
#undef PG8_SB
#undef PG8_STAGE
#undef PG8_LDA
#undef PG8_LDB
#undef PG8_MMA
#undef PG8_WAIT_V
#undef PG8_WAIT_L
#undef PG8_BAR
#undef PG8_SCHED
}
}

using pg8::bf16_t; using pg8::bf16x8; using pg8::f32x4; using pg8::u32x4; using pg8::Unit; using pg8::Gemm; using pg8::StaticOrder; using pg8::cvt_pk_bf16;
#define LAS __attribute__((address_space(3)))
typedef LAS unsigned char* lds_t;
typedef float f32x16 __attribute__((ext_vector_type(16)));
typedef unsigned u32x2 __attribute__((ext_vector_type(2)));

constexpr int S = 8192, DM = 1024, NBATCH = 4, DEPTH = 4, NIN = 7960, NINP = 8192, DFF = 2816, NUP = 5632, SP = S + 64;
constexpr int NB = 2, MT = NB * S, NPASS = NBATCH / NB;
constexpr float EPS = 1e-6f, LOG2E = 1.4426950408889634f, LN2 = 0.6931471805599453f, QSCALE = 0.125f * LOG2E;
constexpr int NTHREADS = 512, LDS_BYTES = 131072 + 16;

constexpr size_t al256(size_t x) { return (x + 255) & ~(size_t)255; }
constexpr size_t O_BAR = 0;
constexpr size_t O_RS1 = 16384;
constexpr size_t O_RS2 = O_RS1 + (size_t)MT * 64;
constexpr size_t O_ROPE = O_RS2 + (size_t)MT * 64;
constexpr size_t O_POSB = O_ROPE + (size_t)S * 32 * 8;
constexpr size_t O_WIN = al256(O_POSB + 8 * 256 * 4);
constexpr size_t SZ_WIN = (size_t)NINP * DM * 2, SZ_WUP = (size_t)NUP * DM * 2, SZ_WDN = (size_t)DM * DFF * 2, SZ_WOUT = (size_t)DM * DM * 2, SZ_WP = (size_t)DM * 512 * 2, SZ_WC1 = (size_t)256 * 2048 * 2;
constexpr size_t O_WUP = O_WIN + 4 * SZ_WIN;
constexpr size_t O_WDN = O_WUP + 4 * SZ_WUP;
constexpr size_t O_WOUT = O_WDN + 4 * SZ_WDN;
constexpr size_t O_WPA = O_WOUT + 4 * SZ_WOUT;
constexpr size_t O_WPB = O_WPA + 4 * SZ_WP;
constexpr size_t O_WC1 = O_WPB + 4 * SZ_WP;
constexpr size_t O_XB = O_WC1 + 8 * SZ_WC1;
constexpr size_t O_QA = O_XB + (size_t)MT * DM * 2;
constexpr size_t SZ_A = (size_t)NB * 24 * S * 64 * 2, SZ_BKV = (size_t)NB * 2 * SP * 64 * 2;
constexpr size_t O_KA = O_QA + SZ_A;
constexpr size_t O_VA = O_KA + SZ_A;
constexpr size_t O_QB = O_VA + SZ_A;
constexpr size_t O_KCR = O_QB + (size_t)NB * 2 * S * 4 * 64 * 2;
constexpr size_t O_VCR = O_KCR + SZ_BKV;
constexpr size_t O_KS = O_VCR + SZ_BKV;
constexpr size_t O_VS = O_KS + SZ_BKV;
constexpr size_t O_KW = O_VS + SZ_BKV;
constexpr size_t O_VW = O_KW + SZ_BKV;
constexpr size_t O_GATE = O_VW + SZ_BKV;
constexpr size_t O_MG = O_GATE + (size_t)MT * 24 * 4;
constexpr size_t O_HID = O_MG + (size_t)MT * 2048 * 2;
constexpr size_t O_KC = O_HID + (size_t)NB * 4 * 512 * 256 * 2;
constexpr size_t O_VC = O_KC + (size_t)NB * 2 * 512 * 64 * 2;
constexpr size_t O_LSE = O_VC + (size_t)NB * 2 * 512 * 64 * 2;
constexpr size_t O_ENDMIX = O_LSE + (size_t)NB * 24 * S * 4;
constexpr size_t O_MIXED = O_KA;
constexpr size_t O_OUTA = O_VA;
constexpr size_t O_OUTB = O_VA + (size_t)MT * 512 * 2;
static_assert((size_t)MT * DM * 2 <= SZ_A && (size_t)2 * MT * 512 * 2 <= SZ_A, "overlay sizes");
constexpr size_t O_GU = O_QA;
constexpr size_t O_ACT = O_GU + (size_t)MT * NUP * 2;
constexpr size_t O_ENDFFN = O_ACT + (size_t)MT * DFF * 2;
constexpr size_t SZ_HALO = (size_t)(MT / 64) * 2 * DFF * 4;
constexpr size_t O_GH = al256(O_ENDMIX > O_ENDFFN ? O_ENDMIX : O_ENDFFN);
constexpr size_t O_G0 = O_GH + SZ_HALO;
constexpr size_t O_U0 = O_G0 + SZ_HALO;
constexpr size_t WS_NEED = O_U0 + SZ_HALO + 4096;

struct Params {
    const float* x; const float* norm_mix_g; const float* w_in; const float* a_q_g; const float* a_k_g; const float* b_q_g; const float* b_k_g;
    const float* cmp_pos; const float* cmp_w1; const float* cmp_w2; const float* w_proj_a; const float* w_proj_b; const float* w_out; const float* norm_ffn_g;
    const float* w_up; const float* conv_w; const float* conv_b; const float* w_down;
    float* out; unsigned char* ws; int ph_lo, ph_hi;
};

__device__ __forceinline__ float bf2f(unsigned short h) { return __uint_as_float((unsigned)h << 16); }
__device__ __forceinline__ float bflo(unsigned w) { return __uint_as_float(w << 16); }
__device__ __forceinline__ float bfhi(unsigned w) { return __uint_as_float(w & 0xffff0000u); }
__device__ __forceinline__ float wave_max(float v) {
#pragma unroll
    for (int o = 1; o < 64; o <<= 1) v = fmaxf(v, __shfl_xor(v, o));
    return v;
}
__device__ __forceinline__ float wave_sum(float v) {
#pragma unroll
    for (int o = 1; o < 64; o <<= 1) v += __shfl_xor(v, o);
    return v;
}
__device__ __forceinline__ float ld_sc1(const float* p) { return __hip_atomic_load(p, __ATOMIC_RELAXED, __HIP_MEMORY_SCOPE_AGENT); }
__device__ __forceinline__ float rs_sum(const float* rs, int row) {
    const f32x4* q = (const f32x4*)(rs + (size_t)row * 16); const f32x4 a = q[0], b = q[1], c = q[2], d = q[3];
    return (((a[0] + a[1]) + (a[2] + a[3])) + ((b[0] + b[1]) + (b[2] + b[3]))) + (((c[0] + c[1]) + (c[2] + c[3])) + ((d[0] + d[1]) + (d[2] + d[3])));
}
__device__ __forceinline__ float rs_sum4(const float* rs, int row, int fq) {
    const f32x4 a = *(const f32x4*)(rs + (size_t)row * 16 + 4 * fq); float s = (a[0] + a[1]) + (a[2] + a[3]);
    s += __shfl_xor(s, 16); s += __shfl_xor(s, 32); return s;
}
__device__ __forceinline__ float sigmoidf_(float v) { return __builtin_amdgcn_rcpf(1.f + __expf(-v)); }

struct EpiIn {
    static constexpr bool PERM = false, AFTER_DRAIN = false, HAS_MID = false;
    const float* rs; const float2* rope; const float* gqa; const float* gka; const float* gqb; const float* gkb;
    unsigned char* ws;
    __device__ __forceinline__ void operator()(const f32x4 (&acc)[2][2][4][2], const Unit& u, int wr, int wc, int fr, int fq) const {
        const int hd = 4 * u.pn + wc;
        if (hd >= 93 && hd < 96) return;
        const int bb = (u.pm * 256) >> 13;
        int mode; const float* gain = nullptr; float osc = 1.f; bf16_t* base = nullptr; int shift = 0; int g4 = 0;
        bool norm = false; int rowmul = 1;
        if (hd < 72) { const int kind = hd / 24, h = hd - kind * 24, gi = h >> 3; shift = 2 * gi; mode = 0;
            base = (bf16_t*)(ws + (kind == 0 ? O_QA : (kind == 1 ? O_KA : O_VA))) + (size_t)(bb * 24 + h) * S * 64;
            if (kind == 0) { norm = true; gain = gqa; osc = QSCALE; } else if (kind == 1) { norm = true; gain = gka; } }
        else if (hd < 80) { const int hq = hd - 72; mode = 0; norm = true; gain = gqb; osc = QSCALE; rowmul = 4; g4 = hq & 3; base = (bf16_t*)(ws + O_QB) + (size_t)(bb * 2 + (hq >> 2)) * S * 4 * 64; }
        else if (hd < 92) { const int idx = hd - 80, br = idx >> 2, kv = (idx >> 1) & 1, kvh = idx & 1; mode = 0;
            const size_t o = br == 0 ? (kv ? O_VCR : O_KCR) : (br == 1 ? (kv ? O_VS : O_KS) : (kv ? O_VW : O_KW));
            base = (bf16_t*)(ws + o) + (size_t)(bb * 2 + kvh) * SP * 64;
            if (kv == 0 && br > 0) { norm = true; gain = gkb + br * 64; } }
        else if (hd == 92) mode = 1; else mode = 2;
        float gn[2][2][4];
        if (norm) {
#pragma unroll
            for (int bj = 0; bj < 2; ++bj)
#pragma unroll
                for (int n = 0; n < 2; ++n) { const f32x4 gv = *(const f32x4*)(gain + 32 * bj + 16 * n + 4 * fq); gn[bj][n][0] = gv[0] * osc; gn[bj][n][1] = gv[1] * osc; gn[bj][n][2] = gv[2] * osc; gn[bj][n][3] = gv[3] * osc; }
        }
#pragma unroll
        for (int ai = 0; ai < 2; ++ai)
#pragma unroll
            for (int m = 0; m < 4; ++m) {
                const int tg = u.pm * 256 + ai * 128 + wr * 64 + m * 16 + fr, t = tg & (S - 1);
                const float rsc = rsqrtf(rs_sum4(rs, tg, fq) * (1.f / DM) + EPS);
                f32x4 v[2][2];
#pragma unroll
                for (int bj = 0; bj < 2; ++bj)
#pragma unroll
                    for (int n = 0; n < 2; ++n) v[bj][n] = acc[ai][bj][m][n] * rsc;
                if (mode == 0) {
                    if (norm) {
                        float ss = 0.f;
#pragma unroll
                        for (int bj = 0; bj < 2; ++bj)
#pragma unroll
                            for (int n = 0; n < 2; ++n) ss += (v[bj][n][0] * v[bj][n][0] + v[bj][n][1] * v[bj][n][1]) + (v[bj][n][2] * v[bj][n][2] + v[bj][n][3] * v[bj][n][3]);
                        ss += __shfl_xor(ss, 16); ss += __shfl_xor(ss, 32);
                        const float r = rsqrtf(ss * (1.f / 64.f) + EPS);
#pragma unroll
                        for (int n = 0; n < 2; ++n) {
                            const f32x4* rp = (const f32x4*)(rope + (size_t)t * 32 + 16 * n + 4 * fq); const f32x4 c01 = rp[0], c23 = rp[1];
#pragma unroll
                            for (int e = 0; e < 4; ++e) { float2 cs; cs.x = e < 2 ? c01[2 * e] : c23[2 * e - 4]; cs.y = e < 2 ? c01[2 * e + 1] : c23[2 * e - 3];
                                const float x1 = v[0][n][e] * r * gn[0][n][e], x2 = v[1][n][e] * r * gn[1][n][e];
                                v[0][n][e] = x1 * cs.x - x2 * cs.y; v[1][n][e] = x2 * cs.x + x1 * cs.y; }
                        }
                    }
                    size_t row;
                    if (rowmul == 4) row = (size_t)t * 4 + g4;
                    else if (hd < 72) { const int L = S >> shift; row = (size_t)(t & ((1 << shift) - 1)) * L + (t >> shift); }
                    else row = t;
                    bf16_t* dp = base + row * 64 + 4 * fq;
#pragma unroll
                    for (int bj = 0; bj < 2; ++bj)
#pragma unroll
                        for (int n = 0; n < 2; ++n) { u32x2 w; w.x = cvt_pk_bf16(v[bj][n][0], v[bj][n][1]); w.y = cvt_pk_bf16(v[bj][n][2], v[bj][n][3]); *(u32x2*)(dp + 32 * bj + 16 * n) = w; }
                } else if (mode == 1) {
                    float* gp = (float*)(ws + O_GATE) + (size_t)tg * 24;
                    { f32x4 o; o[0] = sigmoidf_(v[0][0][0]); o[1] = sigmoidf_(v[0][0][1]); o[2] = sigmoidf_(v[0][0][2]); o[3] = sigmoidf_(v[0][0][3]); *(f32x4*)(gp + 4 * fq) = o; }
                    if (fq < 2) { f32x4 o; o[0] = sigmoidf_(v[0][1][0]); o[1] = sigmoidf_(v[0][1][1]); o[2] = sigmoidf_(v[0][1][2]); o[3] = sigmoidf_(v[0][1][3]); *(f32x4*)(gp + 16 + 4 * fq) = o; }
                } else {
                    bf16_t* dp = (bf16_t*)(ws + O_MG) + (size_t)tg * 2048 + (hd - 96) * 64 + 4 * fq;
#pragma unroll
                    for (int bj = 0; bj < 2; ++bj)
#pragma unroll
                        for (int n = 0; n < 2; ++n) { u32x2 w; w.x = cvt_pk_bf16(sigmoidf_(v[bj][n][0]), sigmoidf_(v[bj][n][1])); w.y = cvt_pk_bf16(sigmoidf_(v[bj][n][2]), sigmoidf_(v[bj][n][3])); *(u32x2*)(dp + 32 * bj + 16 * n) = w; }
                }
            }
    }
};

__device__ __forceinline__ float gelu_tanh(float x) {
    const float u = 0.7978845608028654f * (x + 0.044715f * x * x * x);
    const float e = __expf(2.f * u);
    const float th = 1.f - 2.f * __builtin_amdgcn_rcpf(e + 1.f);
    return 0.5f * x * (1.f + th);
}
struct EpiGelu {
    static constexpr bool PERM = false, AFTER_DRAIN = false, HAS_MID = false;
    bf16_t* O; const float* bias;
    __device__ __forceinline__ void operator()(const f32x4 (&acc)[2][2][4][2], const Unit& u, int wr, int wc, int fr, int fq) const {
        const int col0 = u.pn * 256 + wc * 32 + 4 * fq;
#pragma unroll
        for (int ai = 0; ai < 2; ++ai)
#pragma unroll
            for (int m = 0; m < 4; ++m) { const int row = u.pm * 256 + ai * 128 + wr * 64 + m * 16 + fr;
#pragma unroll
                for (int bj = 0; bj < 2; ++bj)
#pragma unroll
                    for (int n = 0; n < 2; ++n) { const int c = col0 + 128 * bj + 16 * n; const f32x4 bv = *(const f32x4*)(bias + c); const f32x4 a = acc[ai][bj][m][n] + bv;
                        u32x2 w; w.x = cvt_pk_bf16(gelu_tanh(a[0]), gelu_tanh(a[1])); w.y = cvt_pk_bf16(gelu_tanh(a[2]), gelu_tanh(a[3])); *(u32x2*)(O + (size_t)row * 256 + c) = w; } }
    }
};
template <int SECOND> struct EpiProj {
    static constexpr bool PERM = false, AFTER_DRAIN = false, HAS_MID = false;
    bf16_t* O; const bf16_t* mg;
    __device__ __forceinline__ void operator()(const f32x4 (&acc)[2][2][4][2], const Unit& u, int wr, int wc, int fr, int fq) const {
        const int col0 = u.pn * 256 + wc * 32 + 4 * fq;
#pragma unroll
        for (int ai = 0; ai < 2; ++ai)
#pragma unroll
            for (int m = 0; m < 4; ++m) { const int row = u.pm * 256 + ai * 128 + wr * 64 + m * 16 + fr;
#pragma unroll
                for (int bj = 0; bj < 2; ++bj)
#pragma unroll
                    for (int n = 0; n < 2; ++n) { const int c = col0 + 128 * bj + 16 * n; const u32x2 g = *(const u32x2*)(mg + (size_t)row * 2048 + c); const f32x4 a = acc[ai][bj][m][n];
                        float o0 = bflo(g.x) * a[0], o1 = bfhi(g.x) * a[1], o2 = bflo(g.y) * a[2], o3 = bfhi(g.y) * a[3];
#ifdef ABL_NO_A
                        if (!SECOND) { o0 = o1 = o2 = o3 = 0.f; }
#endif
#ifdef ABL_NO_B
                        if (SECOND) { o0 = o1 = o2 = o3 = 0.f; }
#endif
                        bf16_t* op = O + (size_t)row * DM + c;
                        if (SECOND) { const u32x2 p = *(const u32x2*)op; o0 += bflo(p.x); o1 += bfhi(p.x); o2 += bflo(p.y); o3 += bfhi(p.y); }
                        u32x2 w; w.x = cvt_pk_bf16(o0, o1); w.y = cvt_pk_bf16(o2, o3); *(u32x2*)op = w; } }
    }
};
struct EpiProjF {
    static constexpr bool PERM = false, AFTER_DRAIN = false, HAS_MID = true;
    bf16_t* O; const bf16_t* mg;
    __device__ __forceinline__ void mid(f32x4 (&acc)[2][2][4][2], const Unit& u, int wr, int wc, int fr, int fq) const {
        const int col0 = u.pn * 256 + wc * 32 + 4 * fq;
#pragma unroll
        for (int ai = 0; ai < 2; ++ai)
#pragma unroll
            for (int m = 0; m < 4; ++m) { const int row = u.pm * 256 + ai * 128 + wr * 64 + m * 16 + fr;
#pragma unroll
                for (int bj = 0; bj < 2; ++bj)
#pragma unroll
                    for (int n = 0; n < 2; ++n) { const int c = col0 + 128 * bj + 16 * n; const u32x2 ga = *(const u32x2*)(mg + (size_t)row * 2048 + c), gb = *(const u32x2*)(mg + (size_t)row * 2048 + 1024 + c);
                        f32x4 a = acc[ai][bj][m][n];
                        a[0] *= bflo(ga.x) * __builtin_amdgcn_rcpf(bflo(gb.x)); a[1] *= bfhi(ga.x) * __builtin_amdgcn_rcpf(bfhi(gb.x)); a[2] *= bflo(ga.y) * __builtin_amdgcn_rcpf(bflo(gb.y)); a[3] *= bfhi(ga.y) * __builtin_amdgcn_rcpf(bfhi(gb.y));
                        acc[ai][bj][m][n] = a; } }
    }
    __device__ __forceinline__ void operator()(const f32x4 (&acc)[2][2][4][2], const Unit& u, int wr, int wc, int fr, int fq) const {
        const int col0 = u.pn * 256 + wc * 32 + 4 * fq;
#pragma unroll
        for (int ai = 0; ai < 2; ++ai)
#pragma unroll
            for (int m = 0; m < 4; ++m) { const int row = u.pm * 256 + ai * 128 + wr * 64 + m * 16 + fr;
#pragma unroll
                for (int bj = 0; bj < 2; ++bj)
#pragma unroll
                    for (int n = 0; n < 2; ++n) { const int c = col0 + 128 * bj + 16 * n; const u32x2 gb = *(const u32x2*)(mg + (size_t)row * 2048 + 1024 + c); const f32x4 a = acc[ai][bj][m][n];
                        u32x2 w; w.x = cvt_pk_bf16(a[0] * bflo(gb.x), a[1] * bfhi(gb.x)); w.y = cvt_pk_bf16(a[2] * bflo(gb.y), a[3] * bfhi(gb.y)); *(u32x2*)(O + (size_t)row * DM + c) = w; } }
    }
};
struct EpiRes {
    static constexpr bool PERM = false, AFTER_DRAIN = false, HAS_MID = false;
    float* xnew; bf16_t* xb; float* rso;
    __device__ __forceinline__ void operator()(const f32x4 (&acc)[2][2][4][2], const Unit& u, int wr, int wc, int fr, int fq) const {
        const int col0 = u.pn * 256 + wc * 32 + 4 * fq;
#pragma unroll
        for (int ai = 0; ai < 2; ++ai)
#pragma unroll
            for (int m = 0; m < 4; ++m) { const int row = u.pm * 256 + ai * 128 + wr * 64 + m * 16 + fr; float ss = 0.f;
#pragma unroll
                for (int bj = 0; bj < 2; ++bj)
#pragma unroll
                    for (int n = 0; n < 2; ++n) { const int c = col0 + 128 * bj + 16 * n; const size_t off = (size_t)row * DM + c; const u32x2 pv = *(const u32x2*)(xb + off); const f32x4 a = acc[ai][bj][m][n]; f32x4 o; o[0] = bflo(pv.x) + a[0]; o[1] = bfhi(pv.x) + a[1]; o[2] = bflo(pv.y) + a[2]; o[3] = bfhi(pv.y) + a[3];
                        if (xnew) *(f32x4*)(xnew + off) = o; u32x2 w; w.x = cvt_pk_bf16(o[0], o[1]); w.y = cvt_pk_bf16(o[2], o[3]); *(u32x2*)(xb + off) = w;
                        ss += (o[0] * o[0] + o[1] * o[1]) + (o[2] * o[2] + o[3] * o[3]); }
                ss += __shfl_xor(ss, 16); ss += __shfl_xor(ss, 32);
                if (fq == 0) rso[(size_t)row * 16 + u.pn * 4 + wc] = ss; }
    }
};
__device__ __forceinline__ float dpp_ror1(float v) { return __int_as_float(__builtin_amdgcn_update_dpp(0, __float_as_int(v), 0x121, 0xF, 0xF, true)); }
__device__ __forceinline__ float dpp_ror2(float v) { return __int_as_float(__builtin_amdgcn_update_dpp(0, __float_as_int(v), 0x122, 0xF, 0xF, true)); }
struct EpiUpConv {
    static constexpr bool PERM = true, AFTER_DRAIN = false, HAS_MID = false;
    bf16_t* act; const float* rs; const float* cw; const float* cb; float* gh; float* g0; float* u0;
    __device__ __forceinline__ void operator()(const f32x4 (&acc)[2][2][4][2], const Unit& u, int wr, int wc, int fr, int fq) const {
        const int colb = u.pn * 128 + wc * 32 + 8 * fq;
        float rscv[2][4];
#pragma unroll
        for (int ai = 0; ai < 2; ++ai)
#pragma unroll
            for (int m = 0; m < 4; ++m) rscv[ai][m] = rsqrtf(rs_sum4(rs, u.pm * 256 + ai * 128 + wr * 64 + m * 16 + fr, fq) * (1.f / DM) + EPS);
#pragma unroll
        for (int n = 0; n < 2; ++n) {
            const int c = colb + 4 * n;
            const f32x4 w0 = *(const f32x4*)(cw + c), w1 = *(const f32x4*)(cw + DFF + c), w2 = *(const f32x4*)(cw + 2 * DFF + c), bb = *(const f32x4*)(cb + c);
#pragma unroll
            for (int ai = 0; ai < 2; ++ai) {
                const int grp = u.pm * 4 + ai * 2 + wr;
                f32x4 pr1 = {0.f, 0.f, 0.f, 0.f}, pr2 = {0.f, 0.f, 0.f, 0.f};
#pragma unroll
                for (int m = 0; m < 4; ++m) {
                    const int row = u.pm * 256 + ai * 128 + wr * 64 + m * 16 + fr;
                    const float rsc = rscv[ai][m];
                    const f32x4 g = acc[ai][0][m][n] * rsc, uu = acc[ai][1][m][n] * rsc;
                    f32x4 r1, r2;
#pragma unroll
                    for (int e = 0; e < 4; ++e) { r1[e] = dpp_ror1(g[e]); r2[e] = dpp_ror2(g[e]); }
                    if (m == 0 && fr < 2) {
                        *(f32x4*)(g0 + ((size_t)grp * 2 + fr) * DFF + c) = g; *(f32x4*)(u0 + ((size_t)grp * 2 + fr) * DFF + c) = uu;
                    } else {
                        f32x4 o;
#pragma unroll
                        for (int e = 0; e < 4; ++e) { const float p1 = fr >= 1 ? r1[e] : pr1[e], p2 = fr >= 2 ? r2[e] : pr2[e];
                            const float z = bb[e] + w0[e] * p2 + w1[e] * p1 + w2[e] * g[e]; o[e] = z * sigmoidf_(z) * uu[e]; }
                        u32x2 w; w.x = cvt_pk_bf16(o[0], o[1]); w.y = cvt_pk_bf16(o[2], o[3]); *(u32x2*)(act + (size_t)row * DFF + c) = w;
                    }
                    if (m == 3 && fr >= 14) *(f32x4*)(gh + ((size_t)grp * 2 + (fr - 14)) * DFF + c) = g;
                    pr1 = r1; pr2 = r2;
                }
            }
        }
    }
};
struct EpiUp {
    static constexpr bool PERM = false, AFTER_DRAIN = false, HAS_MID = false;
    bf16_t* O; const float* rs;
    __device__ __forceinline__ void operator()(const f32x4 (&acc)[2][2][4][2], const Unit& u, int wr, int wc, int fr, int fq) const {
        const int col0 = u.pn * 256 + wc * 32 + 4 * fq;
#pragma unroll
        for (int ai = 0; ai < 2; ++ai)
#pragma unroll
            for (int m = 0; m < 4; ++m) { const int row = u.pm * 256 + ai * 128 + wr * 64 + m * 16 + fr; const float rsc = rsqrtf(rs_sum4(rs, row, fq) * (1.f / DM) + EPS);
#pragma unroll
                for (int bj = 0; bj < 2; ++bj)
#pragma unroll
                    for (int n = 0; n < 2; ++n) { const int c = col0 + 128 * bj + 16 * n; const f32x4 a = acc[ai][bj][m][n] * rsc;
                        u32x2 w; w.x = cvt_pk_bf16(a[0], a[1]); w.y = cvt_pk_bf16(a[2], a[3]); *(u32x2*)(O + (size_t)row * NUP + c) = w; } }
    }
};

__device__ __forceinline__ void transpose_item(const float* W, int ldn, int srccol0, int nvalid, const float* gain, bf16_t* dst, int K, int k0, LAS float* scr, int lane) {
    const int i = lane & 31;
#pragma unroll 8
    for (int j = 0; j < 32; ++j) { const int kk = 2 * j + (lane >> 5); float v = 0.f; if (i < nvalid) { v = W[(size_t)(k0 + kk) * ldn + srccol0 + i]; if (gain) v *= gain[k0 + kk]; } scr[kk * 33 + i] = v; }
    asm volatile("s_waitcnt lgkmcnt(0)" ::: "memory");
    const int c = lane & 7;
#pragma unroll
    for (int j = 0; j < 4; ++j) { const int n = (lane >> 3) + 8 * j; const LAS float* s = scr + (8 * c) * 33 + n;
        u32x4 o; o.x = cvt_pk_bf16(s[0 * 33], s[1 * 33]); o.y = cvt_pk_bf16(s[2 * 33], s[3 * 33]); o.z = cvt_pk_bf16(s[4 * 33], s[5 * 33]); o.w = cvt_pk_bf16(s[6 * 33], s[7 * 33]);
        *(u32x4*)(dst + (size_t)n * K + k0 + 8 * c) = o; }
    asm volatile("s_waitcnt lgkmcnt(0)" ::: "memory");
}
__device__ __forceinline__ void win_map(int n0, int& col0, int& nvalid) {
    const int pn = n0 >> 8, j = n0 & 255, bj = j >> 7, wc = (j & 127) >> 5, hd = 4 * pn + wc; nvalid = 32;
    if (hd < 92) col0 = 64 * hd + 32 * bj;
    else if (hd == 92) { col0 = 5888; nvalid = bj == 0 ? 24 : 0; }
    else if (hd < 96) { col0 = 0; nvalid = 0; }
    else col0 = 5912 + 64 * (hd - 96) + 32 * bj;
}
__device__ __forceinline__ void phase_prologue(const Params& p, lds_t lds) {
    const int tid = otid(), wave = tid >> 6, lane = tid & 63;
    LAS float* scr = (LAS float*)(lds + wave * 16384);
    const int gw = blockIdx.x * 8 + wave, NGW = gridDim.x * 8;
    constexpr int I_IN = 16 * 256, I_UP = 16 * 176, I_DN = 44 * 32, I_OUT = 16 * 32, I_P = 8 * 32, I_C1 = 32 * 8;
    constexpr int PER_L = I_IN + I_UP + I_DN + I_OUT + 2 * I_P + 2 * I_C1;
    for (int it = gw; it < 4 * PER_L; it += NGW) {
        const int l = it / PER_L; int r = it - l * PER_L;
        if (r < I_IN) { const int kb = r / 256, nb = r % 256; int c0, nv; win_map(nb * 32, c0, nv);
            transpose_item(p.w_in + (size_t)l * DM * NIN, NIN, c0, nv, p.norm_mix_g + l * DM, (bf16_t*)(p.ws + O_WIN + l * SZ_WIN) + (size_t)nb * 32 * DM, DM, kb * 64, scr, lane); continue; } r -= I_IN;
        if (r < I_UP) { const int kb = r / 176, nb = r % 176;
            transpose_item(p.w_up + (size_t)l * DM * NUP, NUP, (((nb * 32) >> 7) & 1) * DFF + ((nb * 32) >> 8) * 128 + ((nb * 32) & 127), 32, p.norm_ffn_g + l * DM, (bf16_t*)(p.ws + O_WUP + l * SZ_WUP) + (size_t)nb * 32 * DM, DM, kb * 64, scr, lane); continue; } r -= I_UP;
        if (r < I_DN) { const int kb = r / 32, nb = r % 32;
            transpose_item(p.w_down + (size_t)l * DFF * DM, DM, nb * 32, 32, nullptr, (bf16_t*)(p.ws + O_WDN + l * SZ_WDN) + (size_t)nb * 32 * DFF, DFF, kb * 64, scr, lane); continue; } r -= I_DN;
        if (r < I_OUT) { const int kb = r / 32, nb = r % 32;
            transpose_item(p.w_out + (size_t)l * DM * DM, DM, nb * 32, 32, nullptr, (bf16_t*)(p.ws + O_WOUT + l * SZ_WOUT) + (size_t)nb * 32 * DM, DM, kb * 64, scr, lane); continue; } r -= I_OUT;
        if (r < 2 * I_P) { const int which = r / I_P; r -= which * I_P; const int kb = r / 32, nb = r % 32;
            transpose_item((which ? p.w_proj_b : p.w_proj_a) + (size_t)l * 512 * DM, DM, nb * 32, 32, nullptr, (bf16_t*)(p.ws + O_WPA + l * 2 * SZ_WP) + (size_t)nb * 32 * 1024 + which * 512, 1024, kb * 64, scr, lane); continue; } r -= 2 * I_P;
        { const int kv = r / I_C1; r -= kv * I_C1; const int kb = r / 8, nb = r % 8;
            transpose_item(p.cmp_w1 + (size_t)(l * 2 + kv) * 2048 * 256, 256, nb * 32, 32, nullptr, (bf16_t*)(p.ws + O_WC1 + (size_t)(l * 2 + kv) * SZ_WC1) + (size_t)nb * 32 * 2048, 2048, kb * 64, scr, lane); }
    }
    float2* rope = (float2*)(p.ws + O_ROPE);
    for (int i = blockIdx.x * NTHREADS + tid; i < S * 32; i += gridDim.x * NTHREADS) {
        const int t = i >> 5, d = i & 31;
        const float invf = exp2f(-(float)d * (1.f / 32.f) * 13.287712379549449f);
        const float ang = (float)t * invf;
        const double rev = (double)ang * 0.15915494309189535;
        const double fr = rev - floor(rev + 0.5);
        const float xr = (float)(fr * 6.283185307179586);
        rope[i] = make_float2(cosf(xr), sinf(xr));
    }
    float* posb = (float*)(p.ws + O_POSB);
    LAS float* red = (LAS float*)lds;
    for (int item = blockIdx.x; item < 64; item += gridDim.x) {
        const int lk = item >> 3, n0 = (item & 7) * 32, nn = tid & 31, kp = tid >> 5;
        const float* pe = p.cmp_pos + (size_t)lk * 2048 + kp * 128; const float* w = p.cmp_w1 + (size_t)lk * 2048 * 256 + (size_t)(kp * 128) * 256 + n0 + nn;
        float sacc = 0.f;
#pragma unroll 8
        for (int k = 0; k < 128; ++k) sacc += pe[k] * w[(size_t)k * 256];
        __syncthreads();
        red[kp * 32 + nn] = sacc;
        __syncthreads();
        if (tid < 32) { float t = 0.f;
#pragma unroll
            for (int j = 0; j < 16; ++j) t += red[j * 32 + tid];
            posb[lk * 256 + n0 + tid] = t; }
    }
}
__device__ __forceinline__ void phase_x0(const Params& p, int b) {
    const int tid = otid(), wave = tid >> 6, lane = tid & 63;
    const float* x = p.x + (size_t)b * MT * DM; bf16_t* xb = (bf16_t*)(p.ws + O_XB); float* rs1 = (float*)(p.ws + O_RS1);
    for (int row = blockIdx.x * 8 + wave; row < MT; row += gridDim.x * 8) {
        const f32x4* xr = (const f32x4*)(x + (size_t)row * DM) + lane; u32x2* o = (u32x2*)(xb + (size_t)row * DM) + lane; float s = 0.f;
#pragma unroll
        for (int j = 0; j < 4; ++j) { const f32x4 v = xr[64 * j]; s += (v[0] * v[0] + v[1] * v[1]) + (v[2] * v[2] + v[3] * v[3]); u32x2 w; w.x = cvt_pk_bf16(v[0], v[1]); w.y = cvt_pk_bf16(v[2], v[3]); o[64 * j] = w; }
        s = wave_sum(s);
        if (lane < 16) rs1[(size_t)row * 16 + lane] = lane == 0 ? s : 0.f;
    }
}
__device__ __forceinline__ void zero_f32(float* ptr, int n) {
    for (int i = blockIdx.x * NTHREADS + otid(); i < n; i += gridDim.x * NTHREADS) ptr[i] = 0.f;
}

constexpr int KSTR = 144, ABUF = 2 * 64 * KSTR;
constexpr int LDS_SLC = 2 * ABUF;
constexpr int LDS_MASK = LDS_SLC + 64 * 129 * 4;
__device__ __forceinline__ float dpp_xor1(float v) { return __int_as_float(__builtin_amdgcn_update_dpp(0, __float_as_int(v), 0xB1, 0xF, 0xF, true)); }
__device__ __forceinline__ float dpp_xor2(float v) { return __int_as_float(__builtin_amdgcn_update_dpp(0, __float_as_int(v), 0x4E, 0xF, 0xF, true)); }

__device__ __forceinline__ u32x4 ld16_sc1(const void* ptr) {
#ifdef ABL_SC1
    u32x4 v; asm volatile("global_load_dwordx4 %0, %1, off sc0 sc1\n\ts_waitcnt vmcnt(0)" : "=v"(v) : "v"(ptr) : "memory"); return v;
#else
    return *(const u32x4*)ptr;
#endif
}
typedef float f32x2_t __attribute__((ext_vector_type(2))); typedef __bf16 bf16x2_t __attribute__((ext_vector_type(2)));
__device__ __forceinline__ unsigned cvtpk_s(float lo, float hi) { f32x2_t v = {lo, hi}; bf16x2_t b = __builtin_convertvector(v, bf16x2_t); return __builtin_bit_cast(unsigned, b); }
__device__ __forceinline__ float xhalf_sum(float v) {
    auto rr = __builtin_amdgcn_permlane32_swap(__float_as_uint(v), __float_as_uint(v), false, false);
    return __uint_as_float(rr[0]) + __uint_as_float(rr[1]);
}
struct AP { int qpos; int wlo, whi; unsigned m0, m1, m2, m3; int cur; float inv; int tokl; };

template <int MODE>
__device__ __forceinline__ void attn_tiles(lds_t lds, const bf16_t* Kg, const bf16_t* Vg, int tile_lo, int tile_hi, const bf16x8 (&qf)[4], float negM,
                                           f32x16& o0, f32x16& o1, float& l, const AP& ap) {
    if (tile_lo > tile_hi) return;
    const int tid = otid(), lane = tid & 63, r32 = lane & 31, hi = lane >> 5;
    const int lrow = tid >> 3, lch = tid & 7;
    const int vrow = tid & 63, vch = tid >> 6;
    const int vcol = (vrow & ~15) | (vrow & 3) | ((vrow & 4) << 1) | ((vrow & 8) >> 1);
    u32x4 kreg, vreg;
    { kreg = *(const u32x4*)(Kg + ((size_t)(tile_lo * 64 + lrow) * 64 + lch * 8)); if (MODE != 1) vreg = *(const u32x4*)(Vg + ((size_t)(tile_lo * 64 + vrow) * 64 + vch * 8)); }
    int bi = 0;
    for (int i = tile_lo; i <= tile_hi; ++i, bi ^= 1) {
        lds_t kb = lds + bi * ABUF, vb = kb + 64 * KSTR;
        *(LAS u32x4*)(kb + lrow * KSTR + lch * 16) = kreg;
        if (MODE != 1) {
            LAS unsigned short* vp = (LAS unsigned short*)(vb + (8 * vch) * KSTR + vcol * 2);
            vp[0 * (KSTR / 2)] = (unsigned short)(vreg.x & 0xffff); vp[1 * (KSTR / 2)] = (unsigned short)(vreg.x >> 16);
            vp[2 * (KSTR / 2)] = (unsigned short)(vreg.y & 0xffff); vp[3 * (KSTR / 2)] = (unsigned short)(vreg.y >> 16);
            vp[4 * (KSTR / 2)] = (unsigned short)(vreg.z & 0xffff); vp[5 * (KSTR / 2)] = (unsigned short)(vreg.z >> 16);
            vp[6 * (KSTR / 2)] = (unsigned short)(vreg.w & 0xffff); vp[7 * (KSTR / 2)] = (unsigned short)(vreg.w >> 16);
        }
        __syncthreads();
        if (i < tile_hi) { kreg = *(const u32x4*)(Kg + ((size_t)((i + 1) * 64 + lrow) * 64 + lch * 8)); if (MODE != 1) vreg = *(const u32x4*)(Vg + ((size_t)((i + 1) * 64 + vrow) * 64 + vch * 8)); }
        bool need;
        const int kvt = i * 64;
        if (MODE == 0) need = (kvt + 63 >= ap.wlo - 128) && (kvt <= ap.whi);
        else if (MODE == 1 || MODE == 2) need = kvt <= ap.whi;
        else if (MODE == 3) { const unsigned w = (i < 32) ? ap.m0 : (i < 64 ? ap.m1 : (i < 96 ? ap.m2 : ap.m3)); need = __any((int)((w >> (i & 31)) & 1u)) != 0; }
        else need = true;
        if (__builtin_amdgcn_readfirstlane((int)need)) {
            f32x16 p0, p1;
            bool bit = true;
            if (MODE == 3) { const unsigned w = (i < 32) ? ap.m0 : (i < 64 ? ap.m1 : (i < 96 ? ap.m2 : ap.m3)); bit = (w >> (i & 31)) & 1u; }
            const bool full = (MODE == 3) ? (i < ap.cur) : false;
            const float cinit = (MODE == 3 && !bit) ? -3.0e38f : negM;
#pragma unroll
            for (int r = 0; r < 16; ++r) { p0[r] = cinit; p1[r] = cinit; }
            bf16x8 kf[8];
#pragma unroll
            for (int s = 0; s < 4; ++s) {
                kf[2 * s] = *(const LAS bf16x8*)(kb + r32 * KSTR + (16 * s + 8 * hi) * 2);
                kf[2 * s + 1] = *(const LAS bf16x8*)(kb + (r32 + 32) * KSTR + (16 * s + 8 * hi) * 2);
            }
            __builtin_amdgcn_sched_barrier(0);
#pragma unroll
            for (int s = 0; s < 4; ++s) {
                p0 = __builtin_amdgcn_mfma_f32_32x32x16_bf16(kf[2 * s], qf[s], p0, 0, 0, 0);
                p1 = __builtin_amdgcn_mfma_f32_32x32x16_bf16(kf[2 * s + 1], qf[s], p1, 0, 0, 0);
            }
            __builtin_amdgcn_sched_barrier(0);
            bf16x8 vf[8];
            if (MODE != 1) {
#pragma unroll
                for (int kk = 0; kk < 2; ++kk)
#pragma unroll
                    for (int dt = 0; dt < 2; ++dt) vf[kk * 2 + dt] = *(const LAS bf16x8*)(vb + (32 * dt + r32) * KSTR + (16 * kk + 8 * hi) * 2);
            }
            __builtin_amdgcn_sched_barrier(0);
            const int kv0 = kvt + 4 * hi;
            float ls = 0.f;
            if (full) {
#pragma unroll
                for (int r = 0; r < 16; ++r) { const float e0 = __builtin_amdgcn_exp2f(p0[r]), e1 = __builtin_amdgcn_exp2f(p1[r]); p0[r] = e0; p1[r] = e1; ls += e0 + e1; }
            } else
#pragma unroll
            for (int r = 0; r < 16; ++r) {
                const int cr = (r & 3) + 8 * (r >> 2);
                const int k0 = kv0 + cr, k1 = k0 + 32;
                bool v0, v1;
                if (MODE == 0) { v0 = (unsigned)(ap.qpos - k0) <= 128u; v1 = (unsigned)(ap.qpos - k1) <= 128u; }
                else if (MODE == 1 || MODE == 2) { v0 = k0 <= ap.qpos; v1 = k1 <= ap.qpos; }
                else if (MODE == 3) { v0 = bit && (k0 <= ap.qpos); v1 = bit && (k1 <= ap.qpos); }
                else { v0 = (unsigned)(ap.qpos - k0) <= 511u; v1 = (unsigned)(ap.qpos - k1) <= 511u; }
                float e0 = __builtin_amdgcn_exp2f(p0[r]), e1 = __builtin_amdgcn_exp2f(p1[r]);
                e0 = v0 ? e0 : 0.f; e1 = v1 ? e1 : 0.f;
                if (MODE == 2) { e0 *= ap.inv; e1 *= ap.inv; }
                p0[r] = e0; p1[r] = e1; ls += e0 + e1;
            }
            l += ls;
            if (MODE == 2) {
                LAS float* slc = (LAS float*)(lds + LDS_SLC) + ap.tokl * 129;
#pragma unroll
                for (int h = 0; h < 2; ++h)
#pragma unroll
                    for (int rb = 0; rb < 4; ++rb) {
                        float a[4];
#pragma unroll
                        for (int e = 0; e < 4; ++e) { float v = h ? p1[4 * rb + e] : p0[4 * rb + e]; v += dpp_xor1(v); v += dpp_xor2(v); a[e] = v; }
                        const int blk = 16 * i + 2 * rb + hi + 8 * h;
                        if ((r32 & 3) == 0) { (void)__hip_atomic_fetch_add(slc + blk, 2.f * (a[0] + a[1] + a[2]) + a[3], __ATOMIC_RELAXED, __HIP_MEMORY_SCOPE_WORKGROUP); (void)__hip_atomic_fetch_add(slc + blk + 1, a[3], __ATOMIC_RELAXED, __HIP_MEMORY_SCOPE_WORKGROUP); }
                    }
            }
            if (MODE != 1) {
#pragma unroll
                for (int kk = 0; kk < 2; ++kk)
#pragma unroll
                    for (int dt = 0; dt < 2; ++dt) vf[4 + kk * 2 + dt] = *(const LAS bf16x8*)(vb + (32 * dt + r32) * KSTR + (32 + 16 * kk + 8 * hi) * 2);
                __builtin_amdgcn_sched_barrier(0);
#pragma unroll
                for (int h = 0; h < 2; ++h)
#pragma unroll
                    for (int kk = 0; kk < 2; ++kk) {
                        u32x4 pbu;
#pragma unroll
                        for (int j = 0; j < 4; ++j) pbu[j] = h ? cvtpk_s(p1[8 * kk + 2 * j], p1[8 * kk + 2 * j + 1]) : cvtpk_s(p0[8 * kk + 2 * j], p0[8 * kk + 2 * j + 1]);
                        const bf16x8 pbv = __builtin_bit_cast(bf16x8, pbu);
#pragma unroll
                        for (int dt = 0; dt < 2; ++dt) {
                            const bf16x8 avv = vf[(h * 2 + kk) * 2 + dt];
                            if (dt == 0) o0 = __builtin_amdgcn_mfma_f32_32x32x16_bf16(avv, pbv, o0, 0, 0, 0);
                            else o1 = __builtin_amdgcn_mfma_f32_32x32x16_bf16(avv, pbv, o1, 0, 0, 0);
                        }
                    }
            }
        }
#ifdef ABL_SYNC2
        __syncthreads();
#endif
    }
    __syncthreads();
}
__device__ __forceinline__ void load_q(bf16x8 (&qf)[4], const bf16_t* qrow, int hi) {
#pragma unroll
    for (int s = 0; s < 4; ++s) qf[s] = *(const bf16x8*)(qrow + 16 * s + 8 * hi);
}
__device__ __forceinline__ float gain_bound(const float* gq, const float* gk, int lane) {
#ifdef ABL_CONSTM
    return 12.5f;
#endif
    const float mq = wave_max(fabsf(gq[lane])), mk = wave_max(fabsf(gk[lane]));
    return 8.f * mq * mk * LOG2E * 1.02f + 0.05f;
}
__device__ __forceinline__ void zero16(f32x16& v) {
#pragma unroll
    for (int r = 0; r < 16; ++r) v[r] = 0.f;
}

__device__ __forceinline__ void dil_unit(const Params& p, lds_t lds, int l, int unit) {
    const int tid = otid(), wave = __builtin_amdgcn_readfirstlane(tid >> 6), lane = tid & 63, r32 = lane & 31, hi = lane >> 5;
    const int bb = unit / 768, u2 = unit - bb * 768, hd = u2 >> 5, pb = u2 & 31, gi = hd >> 3, shift = 2 * gi, L = S >> shift, bh = bb * 24 + hd;
    const bf16_t* Q = (const bf16_t*)(p.ws + O_QA) + (size_t)bh * S * 64; const bf16_t* K = (const bf16_t*)(p.ws + O_KA) + (size_t)bh * S * 64; const bf16_t* V = (const bf16_t*)(p.ws + O_VA) + (size_t)bh * S * 64;
#ifdef ABL_KQ
    K = Q; V = Q;
#endif
#ifdef ABL_KQ2
    V = K;
#endif
    const int pbase = pb * 256, cs = (pbase / L) * L;
    int lo = pbase - 128; if (lo < cs) lo = cs;
#ifdef ABL_NONEIGH
    lo = pbase;
#endif
    const float negM = -gain_bound(p.a_q_g + l * 64, p.a_k_g + l * 64, lane);
    AP ap; ap.qpos = pbase + 32 * wave + r32; ap.wlo = pbase + 32 * wave; ap.whi = ap.wlo + 31; ap.m0 = ap.m1 = ap.m2 = ap.m3 = 0; ap.cur = 0; ap.inv = 0.f; ap.tokl = 0;
    bf16x8 qf[4]; load_q(qf, Q + (size_t)ap.qpos * 64, hi);
    f32x16 o0, o1; zero16(o0); zero16(o1); float lsum = 0.f;
#ifdef ABL_DIL_Q
#pragma unroll
    for (int r = 0; r < 16; ++r) { o0[r] = bf2f((unsigned short)qf[r & 3][r >> 2]); o1[r] = bf2f((unsigned short)qf[r & 3][4 + (r >> 2)]); }
    lsum = 1.f + 0.01f * (float)r32;
#else
    attn_tiles<0>(lds, K, V, lo >> 6, (pbase + 255) >> 6, qf, negM, o0, o1, lsum, ap);
#endif
#ifdef ABL_DISCARD
    { float* scr = (float*)(p.ws + O_ENDMIX) + ((size_t)unit * 512 + tid) * 36;
#pragma unroll
    for (int r = 0; r < 16; ++r) { scr[r] = o0[r]; scr[16 + r] = o1[r]; o0[r] = bf2f((unsigned short)qf[r & 3][r >> 2]); o1[r] = bf2f((unsigned short)qf[r & 3][4 + (r >> 2)]); }
    scr[32] = lsum; lsum = 1.f + 0.01f * (float)r32; }
#endif
    lsum = xhalf_sum(lsum);
#ifdef ABL_INV1
    const float inv = 30.f;
#else
    const float inv = 1.f / lsum;
#endif
    const int qp = ap.qpos;
    bf16_t* op = (bf16_t*)(p.ws + O_QA) + ((size_t)bh * S + qp) * 64 + 4 * hi;
#pragma unroll
    for (int rb = 0; rb < 4; ++rb) {
        u32x2 w; w.x = cvt_pk_bf16(o0[4 * rb] * inv, o0[4 * rb + 1] * inv); w.y = cvt_pk_bf16(o0[4 * rb + 2] * inv, o0[4 * rb + 3] * inv); *(u32x2*)(op + 8 * rb) = w;
        w.x = cvt_pk_bf16(o1[4 * rb] * inv, o1[4 * rb + 1] * inv); w.y = cvt_pk_bf16(o1[4 * rb + 2] * inv, o1[4 * rb + 3] * inv); *(u32x2*)(op + 32 + 8 * rb) = w;
    }
    if (hi == 0) ((float*)(p.ws + O_LSE))[(size_t)bh * S + qp] = (__log2f(lsum) - negM) * LN2;
}

__device__ __forceinline__ void cmp2_task(const Params& p, int l, int task, int lane) {
    const int bb = task >> 11, idx = (task >> 9) & 3, c = task & 511, kv = idx >> 1, kvh = idx & 1;
    bf16_t* dst = (bf16_t*)(p.ws + (kv ? O_VC : O_KC)) + ((size_t)(bb * 2 + kvh) * 512 + c) * 64;
    if (c == 511) { dst[lane] = 0; return; }
    const bf16_t* hid = (const bf16_t*)(p.ws + O_HID) + ((size_t)(bb * 4 + idx) * 512 + c) * 256;
    const float* w2 = p.cmp_w2 + (size_t)(l * 2 + kv) * 256 * 64 + lane;
    float s = 0.f;
#pragma unroll 8
    for (int k = 0; k < 256; ++k) s += bf2f(hid[k]) * w2[(size_t)k * 64];
    if (kv == 0) {
        const float ss = wave_sum(s * s);
        const float y = s * rsqrtf(ss * (1.f / 64.f) + EPS) * p.b_k_g[(size_t)l * 192 + lane];
        const float other = __shfl_xor(y, 32);
        const float2 cs = ((const float2*)(p.ws + O_ROPE))[(size_t)(16 * c + 31) * 32 + (lane & 31)];
        s = lane < 32 ? (y * cs.x - other * cs.y) : (y * cs.x + other * cs.y);
    }
    const unsigned w = cvt_pk_bf16(s, 0.f);
    dst[lane] = (unsigned short)(w & 0xffff);
}

__device__ __forceinline__ void nsa_unit(const Params& p, lds_t lds, int l, int unit) {
    const int tid = otid(), wave = __builtin_amdgcn_readfirstlane(tid >> 6), lane = tid & 63, r32 = lane & 31, hi = lane >> 5;
    const int kvh = unit & 1, bb = (unit >> 1) & 1, tb = unit >> 2, t0 = tb * 64, cur = tb, bk = bb * 2 + kvh;
    {
        const int tok = tid >> 3, ch = tid & 7, t = t0 + tok, j = 4 * kvh + (ch >> 1), c0 = j * 64 + (ch & 1) * 32;
        const float* lse = (const float*)(p.ws + O_LSE);
        const size_t r0 = (size_t)(bb * 24 + j) * S + t, r1 = (size_t)(bb * 24 + 8 + j) * S + (size_t)(t & 3) * (S >> 2) + (t >> 2), r2 = (size_t)(bb * 24 + 16 + j) * S + (size_t)(t & 15) * (S >> 4) + (t >> 4);
        const float l0 = lse[r0], l1 = lse[r1], l2 = lse[r2];
        const float mx = fmaxf(l0, fmaxf(l1, l2)); float w0 = __expf(l0 - mx), w1 = __expf(l1 - mx), w2 = __expf(l2 - mx); const float is = 1.f / (w0 + w1 + w2); w0 *= is; w1 *= is; w2 *= is;
        const bf16_t* oa = (const bf16_t*)(p.ws + O_QA) + (ch & 1) * 32; bf16_t* out = (bf16_t*)(p.ws + O_OUTA) + ((size_t)bb * S + t) * 1024 + c0;
#pragma unroll
        for (int q = 0; q < 4; ++q) {
            const u32x4 a = *(const u32x4*)(oa + r0 * 64 + 8 * q), b = *(const u32x4*)(oa + r1 * 64 + 8 * q), c = *(const u32x4*)(oa + r2 * 64 + 8 * q);
            u32x4 o;
            o.x = cvt_pk_bf16(w0 * bflo(a.x) + w1 * bflo(b.x) + w2 * bflo(c.x), w0 * bfhi(a.x) + w1 * bfhi(b.x) + w2 * bfhi(c.x));
            o.y = cvt_pk_bf16(w0 * bflo(a.y) + w1 * bflo(b.y) + w2 * bflo(c.y), w0 * bfhi(a.y) + w1 * bfhi(b.y) + w2 * bfhi(c.y));
            o.z = cvt_pk_bf16(w0 * bflo(a.z) + w1 * bflo(b.z) + w2 * bflo(c.z), w0 * bfhi(a.z) + w1 * bfhi(b.z) + w2 * bfhi(c.z));
            o.w = cvt_pk_bf16(w0 * bflo(a.w) + w1 * bflo(b.w) + w2 * bflo(c.w), w0 * bfhi(a.w) + w1 * bfhi(b.w) + w2 * bfhi(c.w));
#ifdef ABL_CONST_OUTA
            { const float f0 = 0.01f * (float)((c0 + 8 * q) % 7) + 0.001f * (float)(t % 5); o.x = cvt_pk_bf16(f0, -f0); o.y = cvt_pk_bf16(f0 * 2.f, f0); o.z = o.x; o.w = o.y; }
#endif
            *(u32x4*)(out + 8 * q) = o;
        }
    }
    const int tokl = 8 * wave + (r32 >> 2), g = r32 & 3, t = t0 + tokl;
    const bf16_t* Q = (const bf16_t*)(p.ws + O_QB) + (((size_t)bk * S + t) * 4 + g) * 64;
    bf16x8 qf[4]; load_q(qf, Q, hi);
    const float* gate = (const float*)(p.ws + O_GATE) + ((size_t)bb * S + t) * 24 + kvh * 4 + g;
    float g_cmp = gate[0], g_sel = gate[8], g_win = gate[16];
#ifdef ABL_NO_CMP
    g_cmp = 0.f;
#endif
#ifdef ABL_NO_SEL
    g_sel = 0.f;
#endif
#ifdef ABL_NO_WIN
    g_win = 0.f;
#endif
    LAS float* slc = (LAS float*)(lds + LDS_SLC); LAS unsigned* maskw = (LAS unsigned*)(lds + LDS_MASK);
    for (int i = tid; i < 64 * 129; i += NTHREADS) slc[i] = 0.f;
    __syncthreads();
    f32x16 acc0, acc1; zero16(acc0); zero16(acc1);
    AP ap; ap.m0 = ap.m1 = ap.m2 = ap.m3 = 0; ap.cur = cur; ap.tokl = tokl; ap.inv = 0.f; ap.wlo = 0;
    {
        const bf16_t* K = (const bf16_t*)(p.ws + O_KC) + (size_t)bk * 512 * 64; const bf16_t* V = (const bf16_t*)(p.ws + O_VC) + (size_t)bk * 512 * 64;
        const float negM = -gain_bound(p.b_q_g + l * 64, p.b_k_g + (size_t)l * 192, lane);
        const int cmax_u = (t0 + 63 - 31) >> 4;
        ap.qpos = (t - 31) >> 4; ap.whi = (t0 + 8 * wave + 7 - 31) >> 4;
        if (cmax_u >= 0) {
            const int thi = cmax_u >> 6;
            f32x16 o0, o1; zero16(o0); zero16(o1); float l1 = 0.f, l2 = 0.f;
            attn_tiles<1>(lds, K, V, 0, thi, qf, negM, o0, o1, l1, ap);
            l1 = xhalf_sum(l1);
            ap.inv = l1 > 0.f ? 1.f / l1 : 0.f;
            attn_tiles<2>(lds, K, V, 0, thi, qf, negM, o0, o1, l2, ap);
#pragma unroll
            for (int r = 0; r < 16; ++r) { acc0[r] = g_cmp * o0[r]; acc1[r] = g_cmp * o1[r]; }
        }
    }
    __syncthreads();
    if (wave == 0) {
        unsigned m0 = 0, m1 = 0, m2 = 0, m3 = 0;
        if (cur < 16) { m0 = (2u << cur) - 1u; }
        else {
            float top[13];
#pragma unroll
            for (int i = 0; i < 13; ++i) top[i] = -2.f;
            const LAS float* sr = slc + lane * 129;
            for (int b = 1; b <= cur - 2; ++b) { float v = sr[b];
#pragma unroll
                for (int i = 0; i < 13; ++i) { const float hi_ = fmaxf(top[i], v); v = fminf(top[i], v); top[i] = hi_; } }
            const float thr = top[12]; int ngt = 0;
            for (int b = 1; b <= cur - 2; ++b) ngt += sr[b] > thr ? 1 : 0;
            int need_eq = 13 - ngt;
            for (int b = 1; b <= cur - 2; ++b) { const float v = sr[b]; bool sel = v > thr; if (!sel && v == thr && need_eq > 0) { sel = true; --need_eq; }
                const unsigned bitv = sel ? (1u << (b & 31)) : 0u;
                if (b < 32) m0 |= bitv; else if (b < 64) m1 |= bitv; else if (b < 96) m2 |= bitv; else m3 |= bitv; }
            m0 |= 1u;
            { const int b = cur; const unsigned bv = 1u << (b & 31); if (b < 32) m0 |= bv; else if (b < 64) m1 |= bv; else if (b < 96) m2 |= bv; else m3 |= bv; }
            { const int b = cur - 1; const unsigned bv = 1u << (b & 31); if (b < 32) m0 |= bv; else if (b < 64) m1 |= bv; else if (b < 96) m2 |= bv; else m3 |= bv; }
        }
        maskw[lane * 4 + 0] = m0; maskw[lane * 4 + 1] = m1; maskw[lane * 4 + 2] = m2; maskw[lane * 4 + 3] = m3;
    }
    __syncthreads();
    ap.m0 = maskw[tokl * 4 + 0]; ap.m1 = maskw[tokl * 4 + 1]; ap.m2 = maskw[tokl * 4 + 2]; ap.m3 = maskw[tokl * 4 + 3];
    ap.qpos = t;
    {
        const bf16_t* K = (const bf16_t*)(p.ws + O_KS) + (size_t)bk * SP * 64; const bf16_t* V = (const bf16_t*)(p.ws + O_VS) + (size_t)bk * SP * 64;
        const float negM = -gain_bound(p.b_q_g + l * 64, p.b_k_g + (size_t)l * 192 + 64, lane);
        f32x16 o0, o1; zero16(o0); zero16(o1); float ls = 0.f;
        attn_tiles<3>(lds, K, V, 0, cur, qf, negM, o0, o1, ls, ap);
        ls = xhalf_sum(ls);
        const float sc = g_sel / ls;
#pragma unroll
        for (int r = 0; r < 16; ++r) { acc0[r] += sc * o0[r]; acc1[r] += sc * o1[r]; }
    }
    {
        const bf16_t* K = (const bf16_t*)(p.ws + O_KW) + (size_t)bk * SP * 64; const bf16_t* V = (const bf16_t*)(p.ws + O_VW) + (size_t)bk * SP * 64;
        const float negM = -gain_bound(p.b_q_g + l * 64, p.b_k_g + (size_t)l * 192 + 128, lane);
        f32x16 o0, o1; zero16(o0); zero16(o1); float ls = 0.f;
        attn_tiles<4>(lds, K, V, cur >= 8 ? cur - 8 : 0, cur, qf, negM, o0, o1, ls, ap);
        ls = xhalf_sum(ls);
        const float sc = g_win / ls;
#pragma unroll
        for (int r = 0; r < 16; ++r) { acc0[r] += sc * o0[r]; acc1[r] += sc * o1[r]; }
    }
    bf16_t* op = (bf16_t*)(p.ws + O_OUTA) + ((size_t)bb * S + t) * 1024 + 512 + (kvh * 4 + g) * 64 + 4 * hi;
#pragma unroll
    for (int rb = 0; rb < 4; ++rb) {
        u32x2 w; w.x = cvt_pk_bf16(acc0[4 * rb], acc0[4 * rb + 1]); w.y = cvt_pk_bf16(acc0[4 * rb + 2], acc0[4 * rb + 3]); *(u32x2*)(op + 8 * rb) = w;
        w.x = cvt_pk_bf16(acc1[4 * rb], acc1[4 * rb + 1]); w.y = cvt_pk_bf16(acc1[4 * rb + 2], acc1[4 * rb + 3]); *(u32x2*)(op + 32 + 8 * rb) = w;
    }
    __syncthreads();
}

__device__ __forceinline__ void phase_conv(const Params& p, int l) {
    bf16_t* act = (bf16_t*)(p.ws + O_ACT); const float* gh = (const float*)(p.ws + O_GH); const float* g0 = (const float*)(p.ws + O_G0); const float* u0 = (const float*)(p.ws + O_U0);
    const float* cw = p.conv_w + (size_t)l * 3 * DFF; const float* cb = p.conv_b + (size_t)l * DFF;
    constexpr int NCH4 = DFF / 4, NGRP = MT / 64;
    for (int it = blockIdx.x * NTHREADS + otid(); it < NCH4 * NGRP; it += gridDim.x * NTHREADS) {
        const int ch = it % NCH4, grp = it / NCH4, c = ch * 4;
        const bool first = (grp & (S / 64 - 1)) == 0;
        const f32x4 z4 = {0.f, 0.f, 0.f, 0.f};
        const f32x4 w0 = *(const f32x4*)(cw + c), w1 = *(const f32x4*)(cw + DFF + c), w2 = *(const f32x4*)(cw + 2 * DFF + c), bb = *(const f32x4*)(cb + c);
        const f32x4 q2 = first ? z4 : *(const f32x4*)(gh + ((size_t)(grp - (first ? 0 : 1)) * 2 + 0) * DFF + c), q1 = first ? z4 : *(const f32x4*)(gh + ((size_t)(grp - (first ? 0 : 1)) * 2 + 1) * DFF + c);
        const f32x4 ga = *(const f32x4*)(g0 + ((size_t)grp * 2 + 0) * DFF + c), gb = *(const f32x4*)(g0 + ((size_t)grp * 2 + 1) * DFF + c);
        const f32x4 ua = *(const f32x4*)(u0 + ((size_t)grp * 2 + 0) * DFF + c), ub = *(const f32x4*)(u0 + ((size_t)grp * 2 + 1) * DFF + c);
        f32x4 oa, ob;
#pragma unroll
        for (int e = 0; e < 4; ++e) { const float za = bb[e] + w0[e] * q2[e] + w1[e] * q1[e] + w2[e] * ga[e]; oa[e] = za * sigmoidf_(za) * ua[e];
            const float zb = bb[e] + w0[e] * q1[e] + w1[e] * ga[e] + w2[e] * gb[e]; ob[e] = zb * sigmoidf_(zb) * ub[e]; }
        u32x2 w; w.x = cvt_pk_bf16(oa[0], oa[1]); w.y = cvt_pk_bf16(oa[2], oa[3]); *(u32x2*)(act + ((size_t)grp * 64 + 0) * DFF + c) = w;
        w.x = cvt_pk_bf16(ob[0], ob[1]); w.y = cvt_pk_bf16(ob[2], ob[3]); *(u32x2*)(act + ((size_t)grp * 64 + 1) * DFF + c) = w;
    }
}

#ifndef PHEN
#define PHEN 0xFFFF
#endif
#define EN(n) (((PHEN) >> (n)) & 1)
__device__ __forceinline__ void my_grid_bar(unsigned* bar) {
    asm volatile("s_waitcnt vmcnt(0) lgkmcnt(0)" ::: "memory");
    __syncthreads();
    if (threadIdx.x == 0) {
        const unsigned G = gridDim.x;
        __builtin_amdgcn_fence(__ATOMIC_RELEASE, "agent");
        asm volatile("s_waitcnt vmcnt(0)" ::: "memory");
        const unsigned g0 = __hip_atomic_load(bar + 64, __ATOMIC_RELAXED, __HIP_MEMORY_SCOPE_AGENT);
        const unsigned old = __hip_atomic_fetch_add(bar, 1u, __ATOMIC_RELAXED, __HIP_MEMORY_SCOPE_AGENT);
        const unsigned base = (old >= 0xAAAAAAAAu && old - 0xAAAAAAAAu < G) ? 0xAAAAAAAAu : 0u;
        if (old - base == G - 1u) { __hip_atomic_store(bar, 0u, __ATOMIC_RELAXED, __HIP_MEMORY_SCOPE_AGENT); (void)__hip_atomic_fetch_add(bar + 64, 1u, __ATOMIC_RELEASE, __HIP_MEMORY_SCOPE_AGENT); }
        else while (__hip_atomic_load(bar + 64, __ATOMIC_RELAXED, __HIP_MEMORY_SCOPE_AGENT) == g0) __builtin_amdgcn_s_sleep(2);
        __builtin_amdgcn_fence(__ATOMIC_ACQUIRE, "agent");
        asm volatile("s_waitcnt vmcnt(0)" ::: "memory");
    }
    __syncthreads();
}
#define XB_TMO      128
#define XB_XCNT(j)  (256  + 64 * (j))
#define XB_XSUB(j)  (1280 + 64 * (j))
#define XB_XGEN(j)  (2304 + 64 * (j))
#define XB_TOP      3328
#define XB_TOPGEN   3392
#define XCD_BAR_WORDS 3456
#define XB_SPIN_CAP (1u << 18)

__device__ __forceinline__ unsigned xb_ld(unsigned* p)              { return __hip_atomic_load(p, __ATOMIC_RELAXED, __HIP_MEMORY_SCOPE_AGENT); }
__device__ __forceinline__ unsigned xb_add(unsigned* p, unsigned v) { return __hip_atomic_fetch_add(p, v, __ATOMIC_RELAXED, __HIP_MEMORY_SCOPE_AGENT); }
__device__ __forceinline__ unsigned xb_xcc_id() { return (unsigned)__builtin_amdgcn_s_getreg((3 << 11) | 20) & 0xFu; }
#define XB_SPIN(cond, bar) do { unsigned _sp = 0; while (cond) { __builtin_amdgcn_s_sleep(1); \
    if ((++_sp & 255u) == 0u) { if (xb_ld(&(bar)[XB_TMO])) break; if (_sp > XB_SPIN_CAP) { atomicAdd(&(bar)[XB_TMO], 1u); break; } } } } while (0)

struct XcdBarrier {
    unsigned* bar; unsigned x;
    volatile LAS unsigned* st;
};

__device__ __forceinline__ XcdBarrier xcd_barrier_post(unsigned* bar, volatile LAS unsigned* st) {
    XcdBarrier b; b.bar = bar; b.x = xb_xcc_id(); b.st = st;
    if (threadIdx.x == 0) (void)xb_add(&bar[XB_XCNT(b.x)], 1u);
    return b;
}
__device__ __forceinline__ void xcd_barrier_complete(unsigned* bar, unsigned x, unsigned& nloc, unsigned& nx) {
    const unsigned G = gridDim.x * gridDim.y * gridDim.z;
    unsigned sum, cnt, mine, sp = 0u;
    for (;;) {
        sum = 0u; cnt = 0u; mine = 0u;
#pragma unroll
        for (unsigned j = 0; j < 16; ++j) { const unsigned c = xb_ld(&bar[XB_XCNT(j)]); sum += c; cnt += (c > 0u) ? 1u : 0u; mine = (j == x) ? c : mine; }
        if (sum == G) break;
        __builtin_amdgcn_s_sleep(1);
        if ((++sp & 255u) == 0u) { if (xb_ld(&bar[XB_TMO])) break; if (sp > XB_SPIN_CAP) { atomicAdd(&bar[XB_TMO], 1u); break; } }
    }
    nloc = mine > 0u ? mine : 1u; nx = cnt > 0u ? cnt : 1u;
}

__device__ __forceinline__ void xcd_barrier(const XcdBarrier& b) {
    asm volatile("s_waitcnt vmcnt(0)" ::: "memory");
    __syncthreads();
    if (threadIdx.x == 0) {
        unsigned* bar = b.bar;
        __builtin_amdgcn_s_waitcnt(0);
        unsigned nloc = b.st[0], nx = b.st[1];
        if (nloc == 0u) { xcd_barrier_complete(bar, b.x, nloc, nx); b.st[0] = nloc; b.st[1] = nx; }
        const unsigned old = xb_add(&bar[XB_XSUB(b.x)], 1u);
        const unsigned gen = old / nloc;
        if (old + 1u == (gen + 1u) * nloc) {
            __builtin_amdgcn_fence(__ATOMIC_RELEASE, "agent");
            asm volatile("s_waitcnt vmcnt(0)" ::: "memory");
            const unsigned og = xb_add(&bar[XB_TOP], 1u);
            const unsigned tg = og / nx;
            if (og + 1u == (tg + 1u) * nx) xb_add(&bar[XB_TOPGEN], 1u);
            else XB_SPIN(xb_ld(&bar[XB_TOPGEN]) == tg, bar);
            __builtin_amdgcn_fence(__ATOMIC_ACQUIRE, "agent");
            xb_add(&bar[XB_XGEN(b.x)], 1u);
            asm volatile("s_waitcnt vmcnt(0)" ::: "memory");
        } else {
            XB_SPIN(xb_ld(&bar[XB_XGEN(b.x)]) == gen, bar);
            __builtin_amdgcn_fence(__ATOMIC_ACQUIRE, "agent");
            asm volatile("s_waitcnt vmcnt(0)" ::: "memory");
        }
    }
    __syncthreads();
}
constexpr int STEPS = 9, PER_PASS = 1 + DEPTH * STEPS, NPHASES = 1 + NPASS * PER_PASS;

__global__ void __launch_bounds__(NTHREADS, 2) mega_fwd(Params p) {
    extern __shared__ __attribute__((aligned(16))) unsigned char lds_raw[];
    lds_t lds = (lds_t)lds_raw;
    cg::grid_group grid = cg::this_grid();
    const int G = gridDim.x;
    volatile LAS unsigned* xst = (volatile LAS unsigned*)(lds + 131072);
    if (threadIdx.x == 0) { xst[0] = 0u; xst[1] = 0u; }
    __syncthreads();
    const XcdBarrier xbar = xcd_barrier_post((unsigned*)(p.ws + O_BAR), xst);
#pragma nounroll
    for (int ph = p.ph_lo; ph < p.ph_hi; ++ph) {
        int c = blockIdx.x; asm volatile("" : "+s"(c));
        const int tid = otid(), wave = tid >> 6, lane = tid & 63;
        if (ph == 0) phase_prologue(p, lds);
        else {
            const int q = ph - 1, b = q / PER_PASS, r = q % PER_PASS;
            if (r == 0) phase_x0(p, b);
            else {
                const int l = (r - 1) / STEPS, st = (r - 1) % STEPS;
                unsigned char* ws = p.ws;
                float* xout = p.out + (size_t)b * MT * DM;
                if (st == 0) {
                    Gemm g{(const bf16_t*)(ws + O_XB), (const bf16_t*)(ws + O_WIN + l * SZ_WIN), MT, NINP, DM, DM};
                    StaticOrder so; so.init(MT, NINP, G, c);
                    EpiIn e{(const float*)(ws + O_RS1), (const float2*)(ws + O_ROPE), p.a_q_g + l * 64, p.a_k_g + l * 64, p.b_q_g + l * 64, p.b_k_g + (size_t)l * 192, ws};
                    pg8::gemm_phase<EpiIn, StaticOrder, true, true>(lds, g, so, e);
#ifdef PROBE_IN2
                    pg8::gemm_phase<EpiIn, StaticOrder, true, true>(lds, g, so, e);
#endif
                } else if (st == 1 || st == 2) {
                    if (st == 1) {
#pragma unroll 1
                        for (int idx = 0; idx < 4 * NB; ++idx) { const int bb = idx >> 2, kv = (idx >> 1) & 1, kvh = idx & 1;
                            Gemm g{(const bf16_t*)(ws + (kv ? O_VCR : O_KCR)) + (size_t)(bb * 2 + kvh) * SP * 64, (const bf16_t*)(ws + O_WC1 + (size_t)(l * 2 + kv) * SZ_WC1), 512, 256, 2048, 1024};
                            StaticOrder so; so.init(512, 256, G, (c + G - 2 * idx) % G);
                            EpiGelu e{(bf16_t*)(ws + O_HID) + (size_t)idx * 512 * 256, (const float*)(ws + O_POSB) + (l * 2 + kv) * 256};
                            pg8::gemm_phase<EpiGelu, StaticOrder, true, true>(lds, g, so, e);
                        }
                    } else {
                        for (int task = c * 8 + wave; task < NB * 2048; task += G * 8) cmp2_task(p, l, task, lane);
                    }
                    constexpr int HALF_U = NB * 768 / 2;
                    const int u0 = st == 1 ? 0 : HALF_U;
                    if (st == 1) {
                        unsigned* ctr = (unsigned*)(ws + O_BAR) + 3600 + (b * DEPTH + l);
                        volatile LAS unsigned* slot = (volatile LAS unsigned*)(lds + 131072 + 8);
                        for (;;) {
                            __syncthreads();
                            if (threadIdx.x == 0) slot[0] = __hip_atomic_fetch_add(ctr, 1u, __ATOMIC_RELAXED, __HIP_MEMORY_SCOPE_AGENT);
                            __syncthreads();
                            const int u = (int)slot[0];
                            if (u >= HALF_U) break;
                            dil_unit(p, lds, l, u);
                        }
                    } else
                    for (int u = u0 + c; u < u0 + HALF_U; u += G) dil_unit(p, lds, l, u);
                } else if (st == 3) {
                    constexpr int NU = NB * 256;
                    for (int u = c; u < NU / 2; u += G) { nsa_unit(p, lds, l, NU - 1 - u); nsa_unit(p, lds, l, u); }
#ifdef PROBE_NSA2
                    for (int u = c; u < NU / 2; u += G) { nsa_unit(p, lds, l, NU - 1 - u); nsa_unit(p, lds, l, u); }
#endif
                } else if (st == 4) {
                    { Gemm g{(const bf16_t*)(ws + O_OUTA), (const bf16_t*)(ws + O_WPA + l * 2 * SZ_WP), MT, DM, 1024, 1024};
                      StaticOrder so; so.init(MT, DM, G, c); EpiProjF e{(bf16_t*)(ws + O_MIXED), (const bf16_t*)(ws + O_MG)};
                      pg8::gemm_phase<EpiProjF, StaticOrder, true, true>(lds, g, so, e); }
                } else if (st == 5) {
                    Gemm g{(const bf16_t*)(ws + O_MIXED), (const bf16_t*)(ws + O_WOUT + l * SZ_WOUT), MT, DM, DM, DM};
                    StaticOrder so; so.init(MT, DM, G, c);
                    EpiRes e{nullptr, (bf16_t*)(ws + O_XB), (float*)(ws + O_RS2)};
                    pg8::gemm_phase<EpiRes, StaticOrder, true, true>(lds, g, so, e);
                } else if (st == 6) {
                    Gemm g{(const bf16_t*)(ws + O_XB), (const bf16_t*)(ws + O_WUP + l * SZ_WUP), MT, NUP, DM, DM};
                    StaticOrder so; so.init(MT, NUP, G, c);
                    EpiUpConv e{(bf16_t*)(ws + O_ACT), (const float*)(ws + O_RS2), p.conv_w + (size_t)l * 3 * DFF, p.conv_b + (size_t)l * DFF, (float*)(ws + O_GH), (float*)(ws + O_G0), (float*)(ws + O_U0)};
                    pg8::gemm_phase<EpiUpConv, StaticOrder, true, true>(lds, g, so, e);
                } else if (st == 7) {
                    phase_conv(p, l);
                } else {
                    Gemm g{(const bf16_t*)(ws + O_ACT), (const bf16_t*)(ws + O_WDN + l * SZ_WDN), MT, DM, DFF, DFF};
                    StaticOrder so; so.init(MT, DM, G, c);
                    EpiRes e{l == DEPTH - 1 ? xout : nullptr, (bf16_t*)(ws + O_XB), (float*)(ws + O_RS1)};
                    pg8::gemm_phase<EpiRes, StaticOrder, true, true>(lds, g, so, e);
                }
            }
        }
        if (ph + 1 < p.ph_hi) { xcd_barrier(xbar); if (ph == 0) grid.sync(); }
    }
}

extern "C" void kernel_launch(void* const* d_in, const int* in_sizes, int n_in, void* d_out, int out_size, void* d_ws, size_t ws_size, hipStream_t stream) {
    static int grid = 0;
    if (grid == 0) {
        if (ws_size < WS_NEED) { fprintf(stderr, "kernel_launch: workspace too small: %zu < %zu\n", ws_size, (size_t)WS_NEED); grid = -1; return; }
        int dev = 0, cus = 0, per_cu = 0;
        (void)hipGetDevice(&dev); (void)hipDeviceGetAttribute(&cus, hipDeviceAttributeMultiprocessorCount, dev);
        if (hipFuncSetAttribute((const void*)mega_fwd, hipFuncAttributeMaxDynamicSharedMemorySize, LDS_BYTES) != hipSuccess) { fprintf(stderr, "hipFuncSetAttribute failed\n"); grid = -1; return; }
        (void)hipOccupancyMaxActiveBlocksPerMultiprocessor(&per_cu, (const void*)mega_fwd, NTHREADS, LDS_BYTES);
        (void)hipGetLastError();
        if (per_cu < 1) per_cu = 1;
        grid = cus;
    }
    if (grid < 0) return;
    (void)hipMemsetAsync(d_ws, 0, 16384, stream);
    Params p{};
    const float** pp = (const float**)&p;
    for (int i = 0; i < 18; ++i) pp[i] = (const float*)d_in[i];
    p.out = (float*)d_out; p.ws = (unsigned char*)d_ws;
#ifdef MULTI_LAUNCH
    for (int ph = 0; ph < NPHASES; ++ph) { p.ph_lo = ph; p.ph_hi = ph + 1; hipLaunchKernelGGL(mega_fwd, dim3(grid), dim3(NTHREADS), LDS_BYTES, stream, p); }
#else
    p.ph_lo = 0; p.ph_hi = NPHASES;
    void* args[] = {&p};
    hipError_t e = hipLaunchCooperativeKernel((const void*)mega_fwd, dim3(grid), dim3(NTHREADS), args, LDS_BYTES, stream);
    if (e != hipSuccess) fprintf(stderr, "cooperative launch failed: %s (grid %d)\n", hipGetErrorString(e), grid);
#endif
}
```

```cpp
#include <hip/hip_runtime.h>
#include <hip/hip_cooperative_groups.h>
#include <cstdio>
#include <cstdint>
#include <type_traits>
namespace cg = cooperative_groups;
__device__ __forceinline__ int otid() { int t = threadIdx.x; asm volatile("" : "+v"(t)); return t; }
namespace pg8 {
#define PG8_LAS __attribute__((address_space(3)))
typedef unsigned short bf16_t;
typedef short bf16x8 __attribute__((ext_vector_type(8)));
typedef float f32x4 __attribute__((ext_vector_type(4)));
typedef unsigned u32x4 __attribute__((ext_vector_type(4)));
constexpr int BM = 256, BK = 64, HALF = 128, HTB = HALF * BK * 2  , STAGE_BYTES = 8 * HTB, NXCD = 8, WGM = 8;

__host__ __device__ __forceinline__ int lds_byte(int r, int c) { const int st = (r >> 4) * 2 + (c >> 5), rr = r & 15, cc = c & 31, ob = rr * 64 + cc * 2; return st * 1024 + (ob ^ (((ob >> 9) & 1) << 5)); }
__host__ __device__ __forceinline__ void stage_rc(int b, int& R, int& C) { const int st = b / 1024, sb = b % 1024, swz = sb ^ (((sb >> 9) & 1) << 5); R = (st >> 1) * 16 + swz / 64; C = (st & 1) * 32 + (swz % 64) / 2; }
__host__ __device__ __forceinline__ int perm32(int rho) { const int n = rho >> 4, i = rho & 15; return 8 * (i >> 2) + 4 * n + (i & 3); }

struct Unit { int pm, pn; };
struct Gemm { const bf16_t* A; const bf16_t* Bt; int M, N, K, lda; };

struct StaticOrder {
    int nM, nN, nwg, G, c;
    __host__ __device__ void init(int M, int N, int G_, int c_) { nM = M / BM; nN = N / BM; nwg = nM * nN; G = G_; c = c_; }
    __host__ __device__ bool next(int i, Unit& u) const {
        const long L = (long)i * G + c; if (L >= nwg) return false;
        int wgid = (int)L; { const int q = nwg / NXCD, r = nwg % NXCD, xcd = wgid % NXCD, off = wgid / NXCD; wgid = (xcd < r ? xcd * (q + 1) : r * (q + 1) + (xcd - r) * q) + off; }
        const int nig = WGM * nN, gid = wgid / nig, fm = gid * WGM, gsz = (nM - fm) < WGM ? (nM - fm) : WGM;
        u.pm = fm + ((wgid % nig) % gsz); u.pn = (wgid % nig) / gsz; return true;
    }
    __device__ __forceinline__ void a_ready(const Unit&) const {}
    __device__ __forceinline__ void done(const Unit&) const {}
};

typedef float cvt_f32x2_t __attribute__((ext_vector_type(2))); typedef __bf16 cvt_bf16x2_t __attribute__((ext_vector_type(2)));
__device__ __forceinline__ unsigned cvt_pk_bf16(float lo, float hi) { cvt_f32x2_t v = {lo, hi}; cvt_bf16x2_t b = __builtin_convertvector(v, cvt_bf16x2_t); return __builtin_bit_cast(unsigned, b); }
template <class Epi, class Sched, bool ALIGN_EPI = false, bool SP2 = false>
__device__ __forceinline__ void gemm_phase(PG8_LAS unsigned char* lds, const Gemm g, const Sched& S, const Epi& E) {
    const int tid = otid(), wid = __builtin_amdgcn_readfirstlane(tid >> 6), lane = tid & 63, wr = wid >> 2, wc = wid & 3, fr = lane & 15, fq = lane >> 4;
    const int K = g.K, nt = K / BK;
    unsigned voffA[2], voffB[2];
#pragma unroll
    for (int i = 0; i < 2; ++i) { int R, C; stage_rc(tid * 16 + i * 8192, R, C); const int Rb = Epi::PERM ? ((R & ~31) + perm32(R & 31)) : R;
        voffA[i] = (unsigned)(R * g.lda + C) * 2u; voffB[i] = (unsigned)(Rb * K + C) * 2u; }
    const size_t kstep = (size_t)(BK * 2);
    const size_t hstepB = (size_t)HALF * K * 2, hstepA = (size_t)HALF * g.lda * 2;
    const size_t tstepA = 2 * hstepA, tstepB = 2 * hstepB;
    const unsigned ldsw = (unsigned)wid * 1024u;
    const int aoff = lds_byte(wr * 64 + fr, fq * 8), boff = lds_byte(wc * 32 + fr, fq * 8);
#define PG8_SA(b, h) (((b) * 2 + (h)) * HTB)
#define PG8_SB(b, h) ((4 + (b) * 2 + (h)) * HTB)
#define PG8_STAGE(bufoff, gbase, voff) do { _Pragma("unroll") for (int _i = 0; _i < 2; ++_i) \
        __builtin_amdgcn_global_load_lds((const unsigned*)((const char*)(gbase) + (voff)[_i]), (PG8_LAS unsigned*)(lds + (bufoff) + ldsw + _i * 8192), 16, 0, 0); } while (0)
#define PG8_LDA(dst, b, h) do { _Pragma("unroll") for (int m = 0; m < 4; ++m) _Pragma("unroll") for (int k = 0; k < 2; ++k) dst[m][k] = *(const PG8_LAS bf16x8*)(lds + PG8_SA(b, h) + aoff + m * 2048 + k * 1024); } while (0)
#define PG8_LDB(dst, b, h) do { _Pragma("unroll") for (int n = 0; n < 2; ++n) _Pragma("unroll") for (int k = 0; k < 2; ++k) dst[n][k] = *(const PG8_LAS bf16x8*)(lds + PG8_SB(b, h) + boff + n * 2048 + k * 1024); } while (0)
#define PG8_MMA(ai, bj, At, Bt) do { __builtin_amdgcn_s_setprio(1); _Pragma("unroll") for (int m = 0; m < 4; ++m) _Pragma("unroll") for (int n = 0; n < 2; ++n) _Pragma("unroll") for (int k = 0; k < 2; ++k) \
        acc[ai][bj][m][n] = __builtin_amdgcn_mfma_f32_16x16x32_bf16(Bt[n][k], At[m][k], acc[ai][bj][m][n], 0, 0, 0); __builtin_amdgcn_s_setprio(0); } while (0)
#define PG8_WAIT_V(n) asm volatile("s_waitcnt vmcnt(" #n ")" ::: "memory")
#define PG8_WAIT_L(n) asm volatile("s_waitcnt lgkmcnt(" #n ")" ::: "memory")
#define PG8_BAR __builtin_amdgcn_s_barrier()
#define PG8_SCHED __builtin_amdgcn_sched_barrier(0)
    Unit cur, nxt; int ui = 0;
    if (!S.next(0, cur)) return;
    f32x4 acc[2][2][4][2];
#pragma unroll
    for (int a = 0; a < 2; ++a)
#pragma unroll
        for (int b = 0; b < 2; ++b)
#pragma unroll
            for (int m = 0; m < 4; ++m)
#pragma unroll
                for (int n = 0; n < 2; ++n) acc[a][b][m][n] = (f32x4){0.f, 0.f, 0.f, 0.f};
    bf16x8 At[4][2], B0[2][2], B1[2][2];
    const char* cA = (const char*)g.A + (size_t)cur.pm * tstepA; const char* cB = (const char*)g.Bt + (size_t)cur.pn * tstepB;
    S.a_ready(cur);
    if constexpr (SP2) {
        PG8_STAGE(PG8_SB(0, 0), cB, voffB); PG8_STAGE(PG8_SB(0, 1), cB + hstepB, voffB); PG8_STAGE(PG8_SA(0, 0), cA, voffA); PG8_STAGE(PG8_SA(0, 1), cA + hstepA, voffA);
        if (wr == 1) PG8_BAR;
        PG8_WAIT_V(2); PG8_BAR;
        PG8_STAGE(PG8_SB(1, 0), cB + kstep, voffB); PG8_STAGE(PG8_SA(1, 0), cA + kstep, voffA); PG8_STAGE(PG8_SB(1, 1), cB + hstepB + kstep, voffB);
        PG8_WAIT_V(6); PG8_BAR;
    } else {
        PG8_STAGE(PG8_SB(0, 0), cB, voffB); PG8_STAGE(PG8_SA(0, 0), cA, voffA); PG8_STAGE(PG8_SB(0, 1), cB + hstepB, voffB); PG8_STAGE(PG8_SA(0, 1), cA + hstepA, voffA);
        if (wr == 1) PG8_BAR;
        PG8_WAIT_V(4); PG8_BAR;
        PG8_STAGE(PG8_SB(1, 0), cB + kstep, voffB); PG8_STAGE(PG8_SA(1, 0), cA + kstep, voffA); PG8_STAGE(PG8_SB(1, 1), cB + hstepB + kstep, voffB);
        PG8_WAIT_V(6); PG8_BAR;
    }
    for (;;) {
        const bool has_next = S.next(ui + 1, nxt);
        const char* nA = has_next ? (const char*)g.A + (size_t)nxt.pm * tstepA : cA; const char* nB = has_next ? (const char*)g.Bt + (size_t)nxt.pn * tstepB : cB;
        for (int t = 0; t < nt; t += 2) {
            if constexpr (Epi::HAS_MID) { if (t == (nt >> 1)) E.mid(acc, cur, wr, wc, fr, fq); }
            const bool last = (t == nt - 2);
            const char* a1 = cA + (size_t)(t + 1) * kstep;
            const char* a2 = last ? nA : cA + (size_t)(t + 2) * kstep; const char* b2 = last ? nB : cB + (size_t)(t + 2) * kstep;
            const char* a3 = a2 + kstep; const char* b3 = b2 + kstep;
            if (last && has_next) S.a_ready(nxt);
            if constexpr (SP2) {
            PG8_LDB(B0, 0, 0); PG8_LDB(B1, 0, 1); PG8_SCHED; PG8_LDA(At, 0, 0); PG8_STAGE(PG8_SA(1, 1), a1 + hstepA, voffA);
            PG8_WAIT_V(8); PG8_WAIT_L(0); PG8_BAR; PG8_MMA(0, 0, At, B0); PG8_MMA(0, 1, At, B1); PG8_BAR; PG8_SCHED;
            PG8_LDA(At, 0, 1); PG8_STAGE(PG8_SB(0, 0), b2, voffB); PG8_STAGE(PG8_SB(0, 1), b2 + hstepB, voffB); PG8_STAGE(PG8_SA(0, 0), a2, voffA);
            PG8_WAIT_V(8); PG8_WAIT_L(0); PG8_BAR; PG8_MMA(1, 0, At, B0); PG8_MMA(1, 1, At, B1); PG8_BAR; PG8_SCHED;
            PG8_LDB(B0, 1, 0); PG8_LDB(B1, 1, 1); PG8_SCHED; PG8_LDA(At, 1, 0); PG8_STAGE(PG8_SA(0, 1), a2 + hstepA, voffA);
            PG8_WAIT_V(8); PG8_WAIT_L(0); PG8_BAR; PG8_MMA(0, 0, At, B0); PG8_MMA(0, 1, At, B1); PG8_BAR; PG8_SCHED;
            PG8_LDA(At, 1, 1); PG8_STAGE(PG8_SB(1, 0), b3, voffB); PG8_STAGE(PG8_SB(1, 1), b3 + hstepB, voffB); PG8_STAGE(PG8_SA(1, 0), a3, voffA);
            PG8_WAIT_V(8); PG8_WAIT_L(0); PG8_BAR; PG8_MMA(1, 0, At, B0); PG8_MMA(1, 1, At, B1); PG8_BAR; PG8_SCHED;
            } else {
            PG8_LDB(B0, 0, 0); PG8_SCHED; PG8_LDA(At, 0, 0); PG8_STAGE(PG8_SA(1, 1), a1 + hstepA, voffA);
            PG8_WAIT_L(8); PG8_BAR; PG8_WAIT_L(0); PG8_MMA(0, 0, At, B0); PG8_BAR; PG8_SCHED;
            PG8_LDB(B1, 0, 1); PG8_STAGE(PG8_SB(0, 0), b2, voffB);
            PG8_BAR; PG8_WAIT_L(0); PG8_MMA(0, 1, At, B1); PG8_BAR;
            PG8_LDA(At, 0, 1); PG8_STAGE(PG8_SA(0, 0), a2, voffA);
            PG8_BAR; PG8_WAIT_L(0); PG8_MMA(1, 0, At, B0); PG8_BAR; PG8_SCHED;
            PG8_STAGE(PG8_SB(0, 1), b2 + hstepB, voffB);
            PG8_WAIT_V(6); PG8_BAR; PG8_MMA(1, 1, At, B1); PG8_BAR;
            PG8_LDB(B0, 1, 0); PG8_SCHED; PG8_LDA(At, 1, 0); PG8_STAGE(PG8_SA(0, 1), a2 + hstepA, voffA);
            PG8_WAIT_L(8); PG8_BAR; PG8_WAIT_L(0); PG8_MMA(0, 0, At, B0); PG8_BAR; PG8_SCHED;
            PG8_LDB(B1, 1, 1); PG8_STAGE(PG8_SB(1, 0), b3, voffB);
            PG8_BAR; PG8_WAIT_L(0); PG8_MMA(0, 1, At, B1); PG8_BAR;
            PG8_LDA(At, 1, 1); PG8_STAGE(PG8_SA(1, 0), a3, voffA);
            PG8_BAR; PG8_WAIT_L(0); PG8_MMA(1, 0, At, B0); PG8_BAR; PG8_SCHED;
            PG8_STAGE(PG8_SB(1, 1), b3 + hstepB, voffB);
            PG8_WAIT_V(6); PG8_BAR; PG8_MMA(1, 1, At, B1); PG8_BAR;
            }
        }
        if constexpr (ALIGN_EPI) { if (wr == 0) PG8_BAR; }
        if constexpr (!Epi::AFTER_DRAIN) { E(acc, cur, wr, wc, fr, fq); S.done(cur); }
        if (!has_next) break;
#pragma unroll
        for (int a = 0; a < 2; ++a)
#pragma unroll
            for (int b = 0; b < 2; ++b)
#pragma unroll
                for (int m = 0; m < 4; ++m)
#pragma unroll
                    for (int n = 0; n < 2; ++n) acc[a][b][m][n] = (f32x4){0.f, 0.f, 0.f, 0.f};
        cur = nxt; cA = nA; cB = nB; ++ui;
        if constexpr (ALIGN_EPI) { if (wr == 1) PG8_BAR; }
    }
    PG8_WAIT_V(0);
    if constexpr (!ALIGN_EPI) { if (wr == 0) PG8_BAR; }
    PG8_BAR;
    if constexpr (Epi::AFTER_DRAIN) { E.fused(acc, cur, wr, wc, fr, fq, lds, wid, lane); S.done(cur); }
#undef PG8_SA
#undef PG8_SB
#undef PG8_STAGE
#undef PG8_LDA
#undef PG8_LDB
#undef PG8_MMA
#undef PG8_WAIT_V
#undef PG8_WAIT_L
#undef PG8_BAR
#undef PG8_SCHED
}
}

using pg8::bf16_t; using pg8::bf16x8; using pg8::f32x4; using pg8::u32x4; using pg8::Unit; using pg8::Gemm; using pg8::StaticOrder; using pg8::cvt_pk_bf16;
#define LAS __attribute__((address_space(3)))
typedef LAS unsigned char* lds_t;
typedef float f32x16 __attribute__((ext_vector_type(16)));
typedef unsigned u32x2 __attribute__((ext_vector_type(2)));

constexpr int S = 8192, DM = 1024, NBATCH = 4, DEPTH = 4, NIN = 7960, NINP = 8192, DFF = 2816, NUP = 5632, SP = S + 64;
constexpr int NB = 2, MT = NB * S, NPASS = NBATCH / NB;
constexpr float EPS = 1e-6f, LOG2E = 1.4426950408889634f, LN2 = 0.6931471805599453f, QSCALE = 0.125f * LOG2E;
constexpr int NTHREADS = 512, LDS_BYTES = 131072 + 16;

constexpr size_t al256(size_t x) { return (x + 255) & ~(size_t)255; }
constexpr size_t O_BAR = 0;
constexpr size_t O_RS1 = 16384;
constexpr size_t O_RS2 = O_RS1 + (size_t)MT * 64;
constexpr size_t O_ROPE = O_RS2 + (size_t)MT * 64;
constexpr size_t O_POSB = O_ROPE + (size_t)S * 32 * 8;
constexpr size_t O_WIN = al256(O_POSB + 8 * 256 * 4);
constexpr size_t SZ_WIN = (size_t)NINP * DM * 2, SZ_WUP = (size_t)NUP * DM * 2, SZ_WDN = (size_t)DM * DFF * 2, SZ_WOUT = (size_t)DM * DM * 2, SZ_WP = (size_t)DM * 512 * 2, SZ_WC1 = (size_t)256 * 2048 * 2;
constexpr size_t O_WUP = O_WIN + 4 * SZ_WIN;
constexpr size_t O_WDN = O_WUP + 4 * SZ_WUP;
constexpr size_t O_WOUT = O_WDN + 4 * SZ_WDN;
constexpr size_t O_WPA = O_WOUT + 4 * SZ_WOUT;
constexpr size_t O_WPB = O_WPA + 4 * SZ_WP;
constexpr size_t O_WC1 = O_WPB + 4 * SZ_WP;
constexpr size_t O_XB = O_WC1 + 8 * SZ_WC1;
constexpr size_t O_QA = O_XB + (size_t)MT * DM * 2;
constexpr size_t SZ_A = (size_t)NB * 24 * S * 64 * 2, SZ_BKV = (size_t)NB * 2 * SP * 64 * 2;
constexpr size_t O_KA = O_QA + SZ_A;
constexpr size_t O_VA = O_KA + SZ_A;
constexpr size_t O_QB = O_VA + SZ_A;
constexpr size_t O_KCR = O_QB + (size_t)NB * 2 * S * 4 * 64 * 2;
constexpr size_t O_VCR = O_KCR + SZ_BKV;
constexpr size_t O_KS = O_VCR + SZ_BKV;
constexpr size_t O_VS = O_KS + SZ_BKV;
constexpr size_t O_KW = O_VS + SZ_BKV;
constexpr size_t O_VW = O_KW + SZ_BKV;
constexpr size_t O_GATE = O_VW + SZ_BKV;
constexpr size_t O_MG = O_GATE + (size_t)MT * 24 * 4;
constexpr size_t O_HID = O_MG + (size_t)MT * 2048 * 2;
constexpr size_t O_KC = O_HID + (size_t)NB * 4 * 512 * 256 * 2;
constexpr size_t O_VC = O_KC + (size_t)NB * 2 * 512 * 64 * 2;
constexpr size_t O_LSE = O_VC + (size_t)NB * 2 * 512 * 64 * 2;
constexpr size_t O_ENDMIX = O_LSE + (size_t)NB * 24 * S * 4;
constexpr size_t O_MIXED = O_KA;
constexpr size_t O_OUTA = O_VA;
constexpr size_t O_OUTB = O_VA + (size_t)MT * 512 * 2;
static_assert((size_t)MT * DM * 2 <= SZ_A && (size_t)2 * MT * 512 * 2 <= SZ_A, "overlay sizes");
constexpr size_t O_GU = O_QA;
constexpr size_t O_ACT = O_GU + (size_t)MT * NUP * 2;
constexpr size_t O_ENDFFN = O_ACT + (size_t)MT * DFF * 2;
constexpr size_t SZ_HALO = (size_t)(MT / 64) * 2 * DFF * 4;
constexpr size_t O_GH = al256(O_ENDMIX > O_ENDFFN ? O_ENDMIX : O_ENDFFN);
constexpr size_t O_G0 = O_GH + SZ_HALO;
constexpr size_t O_U0 = O_G0 + SZ_HALO;
constexpr size_t WS_NEED = O_U0 + SZ_HALO + 4096;

struct Params {
    const float* x; const float* norm_mix_g; const float* w_in; const float* a_q_g; const float* a_k_g; const float* b_q_g; const float* b_k_g;
    const float* cmp_pos; const float* cmp_w1; const float* cmp_w2; const float* w_proj_a; const float* w_proj_b; const float* w_out; const float* norm_ffn_g;
    const float* w_up; const float* conv_w; const float* conv_b; const float* w_down;
    float* out; unsigned char* ws; int ph_lo, ph_hi;
};

__device__ __forceinline__ float bf2f(unsigned short h) { return __uint_as_float((unsigned)h << 16); }
__device__ __forceinline__ float bflo(unsigned w) { return __uint_as_float(w << 16); }
__device__ __forceinline__ float bfhi(unsigned w) { return __uint_as_float(w & 0xffff0000u); }
__device__ __forceinline__ float wave_max(float v) {
#pragma unroll
    for (int o = 1; o < 64; o <<= 1) v = fmaxf(v, __shfl_xor(v, o));
    return v;
}
__device__ __forceinline__ float wave_sum(float v) {
#pragma unroll
    for (int o = 1; o < 64; o <<= 1) v += __shfl_xor(v, o);
    return v;
}
__device__ __forceinline__ float ld_sc1(const float* p) { return __hip_atomic_load(p, __ATOMIC_RELAXED, __HIP_MEMORY_SCOPE_AGENT); }
__device__ __forceinline__ float rs_sum(const float* rs, int row) {
    const f32x4* q = (const f32x4*)(rs + (size_t)row * 16); const f32x4 a = q[0], b = q[1], c = q[2], d = q[3];
    return (((a[0] + a[1]) + (a[2] + a[3])) + ((b[0] + b[1]) + (b[2] + b[3]))) + (((c[0] + c[1]) + (c[2] + c[3])) + ((d[0] + d[1]) + (d[2] + d[3])));
}
__device__ __forceinline__ float rs_sum4(const float* rs, int row, int fq) {
    const f32x4 a = *(const f32x4*)(rs + (size_t)row * 16 + 4 * fq); float s = (a[0] + a[1]) + (a[2] + a[3]);
    s += __shfl_xor(s, 16); s += __shfl_xor(s, 32); return s;
}
__device__ __forceinline__ float sigmoidf_(float v) { return __builtin_amdgcn_rcpf(1.f + __expf(-v)); }

struct EpiIn {
    static constexpr bool PERM = false, AFTER_DRAIN = false, HAS_MID = false;
    const float* rs; const float2* rope; const float* gqa; const float* gka; const float* gqb; const float* gkb;
    unsigned char* ws;
    __device__ __forceinline__ void operator()(const f32x4 (&acc)[2][2][4][2], const Unit& u, int wr, int wc, int fr, int fq) const {
        const int hd = 4 * u.pn + wc;
        if (hd >= 93 && hd < 96) return;
        const int bb = (u.pm * 256) >> 13;
        int mode; const float* gain = nullptr; float osc = 1.f; bf16_t* base = nullptr; int shift = 0; int g4 = 0;
        bool norm = false; int rowmul = 1;
        if (hd < 72) { const int kind = hd / 24, h = hd - kind * 24, gi = h >> 3; shift = 2 * gi; mode = 0;
            base = (bf16_t*)(ws + (kind == 0 ? O_QA : (kind == 1 ? O_KA : O_VA))) + (size_t)(bb * 24 + h) * S * 64;
            if (kind == 0) { norm = true; gain = gqa; osc = QSCALE; } else if (kind == 1) { norm = true; gain = gka; } }
        else if (hd < 80) { const int hq = hd - 72; mode = 0; norm = true; gain = gqb; osc = QSCALE; rowmul = 4; g4 = hq & 3; base = (bf16_t*)(ws + O_QB) + (size_t)(bb * 2 + (hq >> 2)) * S * 4 * 64; }
        else if (hd < 92) { const int idx = hd - 80, br = idx >> 2, kv = (idx >> 1) & 1, kvh = idx & 1; mode = 0;
            const size_t o = br == 0 ? (kv ? O_VCR : O_KCR) : (br == 1 ? (kv ? O_VS : O_KS) : (kv ? O_VW : O_KW));
            base = (bf16_t*)(ws + o) + (size_t)(bb * 2 + kvh) * SP * 64;
            if (kv == 0 && br > 0) { norm = true; gain = gkb + br * 64; } }
        else if (hd == 92) mode = 1; else mode = 2;
        float gn[2][2][4];
        if (norm) {
#pragma unroll
            for (int bj = 0; bj < 2; ++bj)
#pragma unroll
                for (int n = 0; n < 2; ++n) { const f32x4 gv = *(const f32x4*)(gain + 32 * bj + 16 * n + 4 * fq); gn[bj][n][0] = gv[0] * osc; gn[bj][n][1] = gv[1] * osc; gn[bj][n][2] = gv[2] * osc; gn[bj][n][3] = gv[3] * osc; }
        }
#pragma unroll
        for (int ai = 0; ai < 2; ++ai)
#pragma unroll
            for (int m = 0; m < 4; ++m) {
                const int tg = u.pm * 256 + ai * 128 + wr * 64 + m * 16 + fr, t = tg & (S - 1);
                const float rsc = rsqrtf(rs_sum4(rs, tg, fq) * (1.f / DM) + EPS);
                f32x4 v[2][2];
#pragma unroll
                for (int bj = 0; bj < 2; ++bj)
#pragma unroll
                    for (int n = 0; n < 2; ++n) v[bj][n] = acc[ai][bj][m][n] * rsc;
                if (mode == 0) {
                    if (norm) {
                        float ss = 0.f;
#pragma unroll
                        for (int bj = 0; bj < 2; ++bj)
#pragma unroll
                            for (int n = 0; n < 2; ++n) ss += (v[bj][n][0] * v[bj][n][0] + v[bj][n][1] * v[bj][n][1]) + (v[bj][n][2] * v[bj][n][2] + v[bj][n][3] * v[bj][n][3]);
                        ss += __shfl_xor(ss, 16); ss += __shfl_xor(ss, 32);
                        const float r = rsqrtf(ss * (1.f / 64.f) + EPS);
#pragma unroll
                        for (int n = 0; n < 2; ++n) {
                            const f32x4* rp = (const f32x4*)(rope + (size_t)t * 32 + 16 * n + 4 * fq); const f32x4 c01 = rp[0], c23 = rp[1];
#pragma unroll
                            for (int e = 0; e < 4; ++e) { float2 cs; cs.x = e < 2 ? c01[2 * e] : c23[2 * e - 4]; cs.y = e < 2 ? c01[2 * e + 1] : c23[2 * e - 3];
                                const float x1 = v[0][n][e] * r * gn[0][n][e], x2 = v[1][n][e] * r * gn[1][n][e];
                                v[0][n][e] = x1 * cs.x - x2 * cs.y; v[1][n][e] = x2 * cs.x + x1 * cs.y; }
                        }
                    }
                    size_t row;
                    if (rowmul == 4) row = (size_t)t * 4 + g4;
                    else if (hd < 72) { const int L = S >> shift; row = (size_t)(t & ((1 << shift) - 1)) * L + (t >> shift); }
                    else row = t;
                    bf16_t* dp = base + row * 64 + 4 * fq;
#pragma unroll
                    for (int bj = 0; bj < 2; ++bj)
#pragma unroll
                        for (int n = 0; n < 2; ++n) { u32x2 w; w.x = cvt_pk_bf16(v[bj][n][0], v[bj][n][1]); w.y = cvt_pk_bf16(v[bj][n][2], v[bj][n][3]); *(u32x2*)(dp + 32 * bj + 16 * n) = w; }
                } else if (mode == 1) {
                    float* gp = (float*)(ws + O_GATE) + (size_t)tg * 24;
                    { f32x4 o; o[0] = sigmoidf_(v[0][0][0]); o[1] = sigmoidf_(v[0][0][1]); o[2] = sigmoidf_(v[0][0][2]); o[3] = sigmoidf_(v[0][0][3]); *(f32x4*)(gp + 4 * fq) = o; }
                    if (fq < 2) { f32x4 o; o[0] = sigmoidf_(v[0][1][0]); o[1] = sigmoidf_(v[0][1][1]); o[2] = sigmoidf_(v[0][1][2]); o[3] = sigmoidf_(v[0][1][3]); *(f32x4*)(gp + 16 + 4 * fq) = o; }
                } else {
                    bf16_t* dp = (bf16_t*)(ws + O_MG) + (size_t)tg * 2048 + (hd - 96) * 64 + 4 * fq;
#pragma unroll
                    for (int bj = 0; bj < 2; ++bj)
#pragma unroll
                        for (int n = 0; n < 2; ++n) { u32x2 w; w.x = cvt_pk_bf16(sigmoidf_(v[bj][n][0]), sigmoidf_(v[bj][n][1])); w.y = cvt_pk_bf16(sigmoidf_(v[bj][n][2]), sigmoidf_(v[bj][n][3])); *(u32x2*)(dp + 32 * bj + 16 * n) = w; }
                }
            }
    }
};

__device__ __forceinline__ float gelu_tanh(float x) {
    const float u = 0.7978845608028654f * (x + 0.044715f * x * x * x);
    const float e = __expf(2.f * u);
    const float th = 1.f - 2.f * __builtin_amdgcn_rcpf(e + 1.f);
    return 0.5f * x * (1.f + th);
}
struct EpiGelu {
    static constexpr bool PERM = false, AFTER_DRAIN = false, HAS_MID = false;
    bf16_t* O; const float* bias;
    __device__ __forceinline__ void operator()(const f32x4 (&acc)[2][2][4][2], const Unit& u, int wr, int wc, int fr, int fq) const {
        const int col0 = u.pn * 256 + wc * 32 + 4 * fq;
#pragma unroll
        for (int ai = 0; ai < 2; ++ai)
#pragma unroll
            for (int m = 0; m < 4; ++m) { const int row = u.pm * 256 + ai * 128 + wr * 64 + m * 16 + fr;
#pragma unroll
                for (int bj = 0; bj < 2; ++bj)
#pragma unroll
                    for (int n = 0; n < 2; ++n) { const int c = col0 + 128 * bj + 16 * n; const f32x4 bv = *(const f32x4*)(bias + c); const f32x4 a = acc[ai][bj][m][n] + bv;
                        u32x2 w; w.x = cvt_pk_bf16(gelu_tanh(a[0]), gelu_tanh(a[1])); w.y = cvt_pk_bf16(gelu_tanh(a[2]), gelu_tanh(a[3])); *(u32x2*)(O + (size_t)row * 256 + c) = w; } }
    }
};
template <int SECOND> struct EpiProj {
    static constexpr bool PERM = false, AFTER_DRAIN = false, HAS_MID = false;
    bf16_t* O; const bf16_t* mg;
    __device__ __forceinline__ void operator()(const f32x4 (&acc)[2][2][4][2], const Unit& u, int wr, int wc, int fr, int fq) const {
        const int col0 = u.pn * 256 + wc * 32 + 4 * fq;
#pragma unroll
        for (int ai = 0; ai < 2; ++ai)
#pragma unroll
            for (int m = 0; m < 4; ++m) { const int row = u.pm * 256 + ai * 128 + wr * 64 + m * 16 + fr;
#pragma unroll
                for (int bj = 0; bj < 2; ++bj)
#pragma unroll
                    for (int n = 0; n < 2; ++n) { const int c = col0 + 128 * bj + 16 * n; const u32x2 g = *(const u32x2*)(mg + (size_t)row * 2048 + c); const f32x4 a = acc[ai][bj][m][n];
                        float o0 = bflo(g.x) * a[0], o1 = bfhi(g.x) * a[1], o2 = bflo(g.y) * a[2], o3 = bfhi(g.y) * a[3];
#ifdef ABL_NO_A
                        if (!SECOND) { o0 = o1 = o2 = o3 = 0.f; }
#endif
#ifdef ABL_NO_B
                        if (SECOND) { o0 = o1 = o2 = o3 = 0.f; }
#endif
                        bf16_t* op = O + (size_t)row * DM + c;
                        if (SECOND) { const u32x2 p = *(const u32x2*)op; o0 += bflo(p.x); o1 += bfhi(p.x); o2 += bflo(p.y); o3 += bfhi(p.y); }
                        u32x2 w; w.x = cvt_pk_bf16(o0, o1); w.y = cvt_pk_bf16(o2, o3); *(u32x2*)op = w; } }
    }
};
struct EpiProjF {
    static constexpr bool PERM = false, AFTER_DRAIN = false, HAS_MID = true;
    bf16_t* O; const bf16_t* mg;
    __device__ __forceinline__ void mid(f32x4 (&acc)[2][2][4][2], const Unit& u, int wr, int wc, int fr, int fq) const {
        const int col0 = u.pn * 256 + wc * 32 + 4 * fq;
#pragma unroll
        for (int ai = 0; ai < 2; ++ai)
#pragma unroll
            for (int m = 0; m < 4; ++m) { const int row = u.pm * 256 + ai * 128 + wr * 64 + m * 16 + fr;
#pragma unroll
                for (int bj = 0; bj < 2; ++bj)
#pragma unroll
                    for (int n = 0; n < 2; ++n) { const int c = col0 + 128 * bj + 16 * n; const u32x2 ga = *(const u32x2*)(mg + (size_t)row * 2048 + c), gb = *(const u32x2*)(mg + (size_t)row * 2048 + 1024 + c);
                        f32x4 a = acc[ai][bj][m][n];
                        a[0] *= bflo(ga.x) * __builtin_amdgcn_rcpf(bflo(gb.x)); a[1] *= bfhi(ga.x) * __builtin_amdgcn_rcpf(bfhi(gb.x)); a[2] *= bflo(ga.y) * __builtin_amdgcn_rcpf(bflo(gb.y)); a[3] *= bfhi(ga.y) * __builtin_amdgcn_rcpf(bfhi(gb.y));
                        acc[ai][bj][m][n] = a; } }
    }
    __device__ __forceinline__ void operator()(const f32x4 (&acc)[2][2][4][2], const Unit& u, int wr, int wc, int fr, int fq) const {
        const int col0 = u.pn * 256 + wc * 32 + 4 * fq;
#pragma unroll
        for (int ai = 0; ai < 2; ++ai)
#pragma unroll
            for (int m = 0; m < 4; ++m) { const int row = u.pm * 256 + ai * 128 + wr * 64 + m * 16 + fr;
#pragma unroll
                for (int bj = 0; bj < 2; ++bj)
#pragma unroll
                    for (int n = 0; n < 2; ++n) { const int c = col0 + 128 * bj + 16 * n; const u32x2 gb = *(const u32x2*)(mg + (size_t)row * 2048 + 1024 + c); const f32x4 a = acc[ai][bj][m][n];
                        u32x2 w; w.x = cvt_pk_bf16(a[0] * bflo(gb.x), a[1] * bfhi(gb.x)); w.y = cvt_pk_bf16(a[2] * bflo(gb.y), a[3] * bfhi(gb.y)); *(u32x2*)(O + (size_t)row * DM + c) = w; } }
    }
};
struct EpiRes {
    static constexpr bool PERM = false, AFTER_DRAIN = false, HAS_MID = false;
    float* xnew; bf16_t* xb; float* rso;
    __device__ __forceinline__ void operator()(const f32x4 (&acc)[2][2][4][2], const Unit& u, int wr, int wc, int fr, int fq) const {
        const int col0 = u.pn * 256 + wc * 32 + 4 * fq;
#pragma unroll
        for (int ai = 0; ai < 2; ++ai)
#pragma unroll
            for (int m = 0; m < 4; ++m) { const int row = u.pm * 256 + ai * 128 + wr * 64 + m * 16 + fr; float ss = 0.f;
#pragma unroll
                for (int bj = 0; bj < 2; ++bj)
#pragma unroll
                    for (int n = 0; n < 2; ++n) { const int c = col0 + 128 * bj + 16 * n; const size_t off = (size_t)row * DM + c; const u32x2 pv = *(const u32x2*)(xb + off); const f32x4 a = acc[ai][bj][m][n]; f32x4 o; o[0] = bflo(pv.x) + a[0]; o[1] = bfhi(pv.x) + a[1]; o[2] = bflo(pv.y) + a[2]; o[3] = bfhi(pv.y) + a[3];
                        if (xnew) *(f32x4*)(xnew + off) = o; u32x2 w; w.x = cvt_pk_bf16(o[0], o[1]); w.y = cvt_pk_bf16(o[2], o[3]); *(u32x2*)(xb + off) = w;
                        ss += (o[0] * o[0] + o[1] * o[1]) + (o[2] * o[2] + o[3] * o[3]); }
                ss += __shfl_xor(ss, 16); ss += __shfl_xor(ss, 32);
                if (fq == 0) rso[(size_t)row * 16 + u.pn * 4 + wc] = ss; }
    }
};
__device__ __forceinline__ float dpp_ror1(float v) { return __int_as_float(__builtin_amdgcn_update_dpp(0, __float_as_int(v), 0x121, 0xF, 0xF, true)); }
__device__ __forceinline__ float dpp_ror2(float v) { return __int_as_float(__builtin_amdgcn_update_dpp(0, __float_as_int(v), 0x122, 0xF, 0xF, true)); }
struct EpiUpConv {
    static constexpr bool PERM = false, AFTER_DRAIN = false, HAS_MID = false;
    bf16_t* act; const float* rs; const float* cw; const float* cb; float* gh; float* g0; float* u0;
    __device__ __forceinline__ void operator()(const f32x4 (&acc)[2][2][4][2], const Unit& u, int wr, int wc, int fr, int fq) const {
        const int colb = u.pn * 128 + wc * 32 + 4 * fq;
        float rscv[2][4];
#pragma unroll
        for (int ai = 0; ai < 2; ++ai)
#pragma unroll
            for (int m = 0; m < 4; ++m) rscv[ai][m] = rsqrtf(rs_sum4(rs, u.pm * 256 + ai * 128 + wr * 64 + m * 16 + fr, fq) * (1.f / DM) + EPS);
#pragma unroll
        for (int n = 0; n < 2; ++n) {
            const int c = colb + 16 * n;
            const f32x4 w0 = *(const f32x4*)(cw + c), w1 = *(const f32x4*)(cw + DFF + c), w2 = *(const f32x4*)(cw + 2 * DFF + c), bb = *(const f32x4*)(cb + c);
#pragma unroll
            for (int ai = 0; ai < 2; ++ai) {
                const int grp = u.pm * 4 + ai * 2 + wr;
                f32x4 pr1 = {0.f, 0.f, 0.f, 0.f}, pr2 = {0.f, 0.f, 0.f, 0.f};
#pragma unroll
                for (int m = 0; m < 4; ++m) {
                    const int row = u.pm * 256 + ai * 128 + wr * 64 + m * 16 + fr;
                    const float rsc = rscv[ai][m];
                    const f32x4 g = acc[ai][0][m][n] * rsc, uu = acc[ai][1][m][n] * rsc;
                    f32x4 r1, r2;
#pragma unroll
                    for (int e = 0; e < 4; ++e) { r1[e] = dpp_ror1(g[e]); r2[e] = dpp_ror2(g[e]); }
                    if (m == 0 && fr < 2) {
                        *(f32x4*)(g0 + ((size_t)grp * 2 + fr) * DFF + c) = g; *(f32x4*)(u0 + ((size_t)grp * 2 + fr) * DFF + c) = uu;
                    } else {
                        f32x4 o;
#pragma unroll
                        for (int e = 0; e < 4; ++e) { const float p1 = fr >= 1 ? r1[e] : pr1[e], p2 = fr >= 2 ? r2[e] : pr2[e];
                            const float z = bb[e] + w0[e] * p2 + w1[e] * p1 + w2[e] * g[e]; o[e] = z * sigmoidf_(z) * uu[e]; }
                        u32x2 w; w.x = cvt_pk_bf16(o[0], o[1]); w.y = cvt_pk_bf16(o[2], o[3]); *(u32x2*)(act + (size_t)row * DFF + c) = w;
                    }
                    if (m == 3 && fr >= 14) *(f32x4*)(gh + ((size_t)grp * 2 + (fr - 14)) * DFF + c) = g;
                    pr1 = r1; pr2 = r2;
                }
            }
        }
    }
};
struct EpiUp {
    static constexpr bool PERM = false, AFTER_DRAIN = false, HAS_MID = false;
    bf16_t* O; const float* rs;
    __device__ __forceinline__ void operator()(const f32x4 (&acc)[2][2][4][2], const Unit& u, int wr, int wc, int fr, int fq) const {
        const int col0 = u.pn * 256 + wc * 32 + 4 * fq;
#pragma unroll
        for (int ai = 0; ai < 2; ++ai)
#pragma unroll
            for (int m = 0; m < 4; ++m) { const int row = u.pm * 256 + ai * 128 + wr * 64 + m * 16 + fr; const float rsc = rsqrtf(rs_sum4(rs, row, fq) * (1.f / DM) + EPS);
#pragma unroll
                for (int bj = 0; bj < 2; ++bj)
#pragma unroll
                    for (int n = 0; n < 2; ++n) { const int c = col0 + 128 * bj + 16 * n; const f32x4 a = acc[ai][bj][m][n] * rsc;
                        u32x2 w; w.x = cvt_pk_bf16(a[0], a[1]); w.y = cvt_pk_bf16(a[2], a[3]); *(u32x2*)(O + (size_t)row * NUP + c) = w; } }
    }
};

__device__ __forceinline__ void transpose_item(const float* W, int ldn, int srccol0, int nvalid, const float* gain, bf16_t* dst, int K, int k0, LAS float* scr, int lane) {
    const int i = lane & 31;
#pragma unroll 8
    for (int j = 0; j < 32; ++j) { const int kk = 2 * j + (lane >> 5); float v = 0.f; if (i < nvalid) { v = W[(size_t)(k0 + kk) * ldn + srccol0 + i]; if (gain) v *= gain[k0 + kk]; } scr[kk * 33 + i] = v; }
    asm volatile("s_waitcnt lgkmcnt(0)" ::: "memory");
    const int c = lane & 7;
#pragma unroll
    for (int j = 0; j < 4; ++j) { const int n = (lane >> 3) + 8 * j; const LAS float* s = scr + (8 * c) * 33 + n;
        u32x4 o; o.x = cvt_pk_bf16(s[0 * 33], s[1 * 33]); o.y = cvt_pk_bf16(s[2 * 33], s[3 * 33]); o.z = cvt_pk_bf16(s[4 * 33], s[5 * 33]); o.w = cvt_pk_bf16(s[6 * 33], s[7 * 33]);
        *(u32x4*)(dst + (size_t)n * K + k0 + 8 * c) = o; }
    asm volatile("s_waitcnt lgkmcnt(0)" ::: "memory");
}
__device__ __forceinline__ void win_map(int n0, int& col0, int& nvalid) {
    const int pn = n0 >> 8, j = n0 & 255, bj = j >> 7, wc = (j & 127) >> 5, hd = 4 * pn + wc; nvalid = 32;
    if (hd < 92) col0 = 64 * hd + 32 * bj;
    else if (hd == 92) { col0 = 5888; nvalid = bj == 0 ? 24 : 0; }
    else if (hd < 96) { col0 = 0; nvalid = 0; }
    else col0 = 5912 + 64 * (hd - 96) + 32 * bj;
}
__device__ __forceinline__ void phase_prologue(const Params& p, lds_t lds) {
    const int tid = otid(), wave = tid >> 6, lane = tid & 63;
    LAS float* scr = (LAS float*)(lds + wave * 16384);
    const int gw = blockIdx.x * 8 + wave, NGW = gridDim.x * 8;
    constexpr int I_IN = 16 * 256, I_UP = 16 * 176, I_DN = 44 * 32, I_OUT = 16 * 32, I_P = 8 * 32, I_C1 = 32 * 8;
    constexpr int PER_L = I_IN + I_UP + I_DN + I_OUT + 2 * I_P + 2 * I_C1;
    for (int it = gw; it < 4 * PER_L; it += NGW) {
        const int l = it / PER_L; int r = it - l * PER_L;
        if (r < I_IN) { const int kb = r / 256, nb = r % 256; int c0, nv; win_map(nb * 32, c0, nv);
            transpose_item(p.w_in + (size_t)l * DM * NIN, NIN, c0, nv, p.norm_mix_g + l * DM, (bf16_t*)(p.ws + O_WIN + l * SZ_WIN) + (size_t)nb * 32 * DM, DM, kb * 64, scr, lane); continue; } r -= I_IN;
        if (r < I_UP) { const int kb = r / 176, nb = r % 176;
            transpose_item(p.w_up + (size_t)l * DM * NUP, NUP, (((nb * 32) >> 7) & 1) * DFF + ((nb * 32) >> 8) * 128 + ((nb * 32) & 127), 32, p.norm_ffn_g + l * DM, (bf16_t*)(p.ws + O_WUP + l * SZ_WUP) + (size_t)nb * 32 * DM, DM, kb * 64, scr, lane); continue; } r -= I_UP;
        if (r < I_DN) { const int kb = r / 32, nb = r % 32;
            transpose_item(p.w_down + (size_t)l * DFF * DM, DM, nb * 32, 32, nullptr, (bf16_t*)(p.ws + O_WDN + l * SZ_WDN) + (size_t)nb * 32 * DFF, DFF, kb * 64, scr, lane); continue; } r -= I_DN;
        if (r < I_OUT) { const int kb = r / 32, nb = r % 32;
            transpose_item(p.w_out + (size_t)l * DM * DM, DM, nb * 32, 32, nullptr, (bf16_t*)(p.ws + O_WOUT + l * SZ_WOUT) + (size_t)nb * 32 * DM, DM, kb * 64, scr, lane); continue; } r -= I_OUT;
        if (r < 2 * I_P) { const int which = r / I_P; r -= which * I_P; const int kb = r / 32, nb = r % 32;
            transpose_item((which ? p.w_proj_b : p.w_proj_a) + (size_t)l * 512 * DM, DM, nb * 32, 32, nullptr, (bf16_t*)(p.ws + O_WPA + l * 2 * SZ_WP) + (size_t)nb * 32 * 1024 + which * 512, 1024, kb * 64, scr, lane); continue; } r -= 2 * I_P;
        { const int kv = r / I_C1; r -= kv * I_C1; const int kb = r / 8, nb = r % 8;
            transpose_item(p.cmp_w1 + (size_t)(l * 2 + kv) * 2048 * 256, 256, nb * 32, 32, nullptr, (bf16_t*)(p.ws + O_WC1 + (size_t)(l * 2 + kv) * SZ_WC1) + (size_t)nb * 32 * 2048, 2048, kb * 64, scr, lane); }
    }
    float2* rope = (float2*)(p.ws + O_ROPE);
    for (int i = blockIdx.x * NTHREADS + tid; i < S * 32; i += gridDim.x * NTHREADS) {
        const int t = i >> 5, d = i & 31;
        const float invf = exp2f(-(float)d * (1.f / 32.f) * 13.287712379549449f);
        const float ang = (float)t * invf;
        const double rev = (double)ang * 0.15915494309189535;
        const double fr = rev - floor(rev + 0.5);
        const float xr = (float)(fr * 6.283185307179586);
        rope[i] = make_float2(cosf(xr), sinf(xr));
    }
    float* posb = (float*)(p.ws + O_POSB);
    LAS float* red = (LAS float*)lds;
    for (int item = blockIdx.x; item < 64; item += gridDim.x) {
        const int lk = item >> 3, n0 = (item & 7) * 32, nn = tid & 31, kp = tid >> 5;
        const float* pe = p.cmp_pos + (size_t)lk * 2048 + kp * 128; const float* w = p.cmp_w1 + (size_t)lk * 2048 * 256 + (size_t)(kp * 128) * 256 + n0 + nn;
        float sacc = 0.f;
#pragma unroll 8
        for (int k = 0; k < 128; ++k) sacc += pe[k] * w[(size_t)k * 256];
        __syncthreads();
        red[kp * 32 + nn] = sacc;
        __syncthreads();
        if (tid < 32) { float t = 0.f;
#pragma unroll
            for (int j = 0; j < 16; ++j) t += red[j * 32 + tid];
            posb[lk * 256 + n0 + tid] = t; }
    }
}
__device__ __forceinline__ void phase_x0(const Params& p, int b) {
    const int tid = otid(), wave = tid >> 6, lane = tid & 63;
    const float* x = p.x + (size_t)b * MT * DM; bf16_t* xb = (bf16_t*)(p.ws + O_XB); float* rs1 = (float*)(p.ws + O_RS1);
    for (int row = blockIdx.x * 8 + wave; row < MT; row += gridDim.x * 8) {
        const f32x4* xr = (const f32x4*)(x + (size_t)row * DM) + lane; u32x2* o = (u32x2*)(xb + (size_t)row * DM) + lane; float s = 0.f;
#pragma unroll
        for (int j = 0; j < 4; ++j) { const f32x4 v = xr[64 * j]; s += (v[0] * v[0] + v[1] * v[1]) + (v[2] * v[2] + v[3] * v[3]); u32x2 w; w.x = cvt_pk_bf16(v[0], v[1]); w.y = cvt_pk_bf16(v[2], v[3]); o[64 * j] = w; }
        s = wave_sum(s);
        if (lane < 16) rs1[(size_t)row * 16 + lane] = lane == 0 ? s : 0.f;
    }
}
__device__ __forceinline__ void zero_f32(float* ptr, int n) {
    for (int i = blockIdx.x * NTHREADS + otid(); i < n; i += gridDim.x * NTHREADS) ptr[i] = 0.f;
}

constexpr int KSTR = 144, ABUF = 2 * 64 * KSTR;
constexpr int LDS_SLC = 2 * ABUF;
constexpr int LDS_MASK = LDS_SLC + 64 * 129 * 4;
__device__ __forceinline__ float dpp_xor1(float v) { return __int_as_float(__builtin_amdgcn_update_dpp(0, __float_as_int(v), 0xB1, 0xF, 0xF, true)); }
__device__ __forceinline__ float dpp_xor2(float v) { return __int_as_float(__builtin_amdgcn_update_dpp(0, __float_as_int(v), 0x4E, 0xF, 0xF, true)); }

__device__ __forceinline__ u32x4 ld16_sc1(const void* ptr) {
#ifdef ABL_SC1
    u32x4 v; asm volatile("global_load_dwordx4 %0, %1, off sc0 sc1\n\ts_waitcnt vmcnt(0)" : "=v"(v) : "v"(ptr) : "memory"); return v;
#else
    return *(const u32x4*)ptr;
#endif
}
typedef float f32x2_t __attribute__((ext_vector_type(2))); typedef __bf16 bf16x2_t __attribute__((ext_vector_type(2)));
__device__ __forceinline__ unsigned cvtpk_s(float lo, float hi) { f32x2_t v = {lo, hi}; bf16x2_t b = __builtin_convertvector(v, bf16x2_t); return __builtin_bit_cast(unsigned, b); }
__device__ __forceinline__ float xhalf_sum(float v) {
    auto rr = __builtin_amdgcn_permlane32_swap(__float_as_uint(v), __float_as_uint(v), false, false);
    return __uint_as_float(rr[0]) + __uint_as_float(rr[1]);
}
struct AP { int qpos; int wlo, whi; unsigned m0, m1, m2, m3; int cur; float inv; int tokl; };

template <int MODE>
__device__ __forceinline__ void attn_tiles(lds_t lds, const bf16_t* Kg, const bf16_t* Vg, int tile_lo, int tile_hi, const bf16x8 (&qf)[4], float negM,
                                           f32x16& o0, f32x16& o1, float& l, const AP& ap) {
    if (tile_lo > tile_hi) return;
    const int tid = otid(), lane = tid & 63, r32 = lane & 31, hi = lane >> 5;
    const int lrow = tid >> 3, lch = tid & 7;
    const int vrow = tid & 63, vch = tid >> 6;
    const int vcol = (vrow & ~15) | (vrow & 3) | ((vrow & 4) << 1) | ((vrow & 8) >> 1);
    u32x4 kreg, vreg;
    { kreg = *(const u32x4*)(Kg + ((size_t)(tile_lo * 64 + lrow) * 64 + lch * 8)); if (MODE != 1) vreg = *(const u32x4*)(Vg + ((size_t)(tile_lo * 64 + vrow) * 64 + vch * 8)); }
    int bi = 0;
    for (int i = tile_lo; i <= tile_hi; ++i, bi ^= 1) {
        lds_t kb = lds + bi * ABUF, vb = kb + 64 * KSTR;
        *(LAS u32x4*)(kb + lrow * KSTR + lch * 16) = kreg;
        if (MODE != 1) {
            LAS unsigned short* vp = (LAS unsigned short*)(vb + (8 * vch) * KSTR + vcol * 2);
            vp[0 * (KSTR / 2)] = (unsigned short)(vreg.x & 0xffff); vp[1 * (KSTR / 2)] = (unsigned short)(vreg.x >> 16);
            vp[2 * (KSTR / 2)] = (unsigned short)(vreg.y & 0xffff); vp[3 * (KSTR / 2)] = (unsigned short)(vreg.y >> 16);
            vp[4 * (KSTR / 2)] = (unsigned short)(vreg.z & 0xffff); vp[5 * (KSTR / 2)] = (unsigned short)(vreg.z >> 16);
            vp[6 * (KSTR / 2)] = (unsigned short)(vreg.w & 0xffff); vp[7 * (KSTR / 2)] = (unsigned short)(vreg.w >> 16);
        }
        __syncthreads();
        if (i < tile_hi) { kreg = *(const u32x4*)(Kg + ((size_t)((i + 1) * 64 + lrow) * 64 + lch * 8)); if (MODE != 1) vreg = *(const u32x4*)(Vg + ((size_t)((i + 1) * 64 + vrow) * 64 + vch * 8)); }
        bool need;
        const int kvt = i * 64;
        if (MODE == 0) need = (kvt + 63 >= ap.wlo - 128) && (kvt <= ap.whi);
        else if (MODE == 1 || MODE == 2) need = kvt <= ap.whi;
        else if (MODE == 3) { const unsigned w = (i < 32) ? ap.m0 : (i < 64 ? ap.m1 : (i < 96 ? ap.m2 : ap.m3)); need = __any((int)((w >> (i & 31)) & 1u)) != 0; }
        else need = true;
        if (__builtin_amdgcn_readfirstlane((int)need)) {
            f32x16 p0, p1;
            bool bit = true;
            if (MODE == 3) { const unsigned w = (i < 32) ? ap.m0 : (i < 64 ? ap.m1 : (i < 96 ? ap.m2 : ap.m3)); bit = (w >> (i & 31)) & 1u; }
            const bool full = (MODE == 3) ? (i < ap.cur) : false;
            const float cinit = (MODE == 3 && !bit) ? -3.0e38f : negM;
#pragma unroll
            for (int r = 0; r < 16; ++r) { p0[r] = cinit; p1[r] = cinit; }
            bf16x8 kf[8];
#pragma unroll
            for (int s = 0; s < 4; ++s) {
                kf[2 * s] = *(const LAS bf16x8*)(kb + r32 * KSTR + (16 * s + 8 * hi) * 2);
                kf[2 * s + 1] = *(const LAS bf16x8*)(kb + (r32 + 32) * KSTR + (16 * s + 8 * hi) * 2);
            }
            __builtin_amdgcn_sched_barrier(0);
#pragma unroll
            for (int s = 0; s < 4; ++s) {
                p0 = __builtin_amdgcn_mfma_f32_32x32x16_bf16(kf[2 * s], qf[s], p0, 0, 0, 0);
                p1 = __builtin_amdgcn_mfma_f32_32x32x16_bf16(kf[2 * s + 1], qf[s], p1, 0, 0, 0);
            }
            __builtin_amdgcn_sched_barrier(0);
            bf16x8 vf[8];
            if (MODE != 1) {
#pragma unroll
                for (int kk = 0; kk < 2; ++kk)
#pragma unroll
                    for (int dt = 0; dt < 2; ++dt) vf[kk * 2 + dt] = *(const LAS bf16x8*)(vb + (32 * dt + r32) * KSTR + (16 * kk + 8 * hi) * 2);
            }
            __builtin_amdgcn_sched_barrier(0);
            const int kv0 = kvt + 4 * hi;
            float ls = 0.f;
            if (full) {
#pragma unroll
                for (int r = 0; r < 16; ++r) { const float e0 = __builtin_amdgcn_exp2f(p0[r]), e1 = __builtin_amdgcn_exp2f(p1[r]); p0[r] = e0; p1[r] = e1; ls += e0 + e1; }
            } else
#pragma unroll
            for (int r = 0; r < 16; ++r) {
                const int cr = (r & 3) + 8 * (r >> 2);
                const int k0 = kv0 + cr, k1 = k0 + 32;
                bool v0, v1;
                if (MODE == 0) { v0 = (unsigned)(ap.qpos - k0) <= 128u; v1 = (unsigned)(ap.qpos - k1) <= 128u; }
                else if (MODE == 1 || MODE == 2) { v0 = k0 <= ap.qpos; v1 = k1 <= ap.qpos; }
                else if (MODE == 3) { v0 = bit && (k0 <= ap.qpos); v1 = bit && (k1 <= ap.qpos); }
                else { v0 = (unsigned)(ap.qpos - k0) <= 511u; v1 = (unsigned)(ap.qpos - k1) <= 511u; }
                float e0 = __builtin_amdgcn_exp2f(p0[r]), e1 = __builtin_amdgcn_exp2f(p1[r]);
                e0 = v0 ? e0 : 0.f; e1 = v1 ? e1 : 0.f;
                if (MODE == 2) { e0 *= ap.inv; e1 *= ap.inv; }
                p0[r] = e0; p1[r] = e1; ls += e0 + e1;
            }
            l += ls;
            if (MODE == 2) {
                LAS float* slc = (LAS float*)(lds + LDS_SLC) + ap.tokl * 129;
#pragma unroll
                for (int h = 0; h < 2; ++h)
#pragma unroll
                    for (int rb = 0; rb < 4; ++rb) {
                        float a[4];
#pragma unroll
                        for (int e = 0; e < 4; ++e) { float v = h ? p1[4 * rb + e] : p0[4 * rb + e]; v += dpp_xor1(v); v += dpp_xor2(v); a[e] = v; }
                        const int blk = 16 * i + 2 * rb + hi + 8 * h;
                        if ((r32 & 3) == 0) { (void)__hip_atomic_fetch_add(slc + blk, 2.f * (a[0] + a[1] + a[2]) + a[3], __ATOMIC_RELAXED, __HIP_MEMORY_SCOPE_WORKGROUP); (void)__hip_atomic_fetch_add(slc + blk + 1, a[3], __ATOMIC_RELAXED, __HIP_MEMORY_SCOPE_WORKGROUP); }
                    }
            }
            if (MODE != 1) {
#pragma unroll
                for (int kk = 0; kk < 2; ++kk)
#pragma unroll
                    for (int dt = 0; dt < 2; ++dt) vf[4 + kk * 2 + dt] = *(const LAS bf16x8*)(vb + (32 * dt + r32) * KSTR + (32 + 16 * kk + 8 * hi) * 2);
                __builtin_amdgcn_sched_barrier(0);
#pragma unroll
                for (int h = 0; h < 2; ++h)
#pragma unroll
                    for (int kk = 0; kk < 2; ++kk) {
                        u32x4 pbu;
#pragma unroll
                        for (int j = 0; j < 4; ++j) pbu[j] = h ? cvtpk_s(p1[8 * kk + 2 * j], p1[8 * kk + 2 * j + 1]) : cvtpk_s(p0[8 * kk + 2 * j], p0[8 * kk + 2 * j + 1]);
                        const bf16x8 pbv = __builtin_bit_cast(bf16x8, pbu);
#pragma unroll
                        for (int dt = 0; dt < 2; ++dt) {
                            const bf16x8 avv = vf[(h * 2 + kk) * 2 + dt];
                            if (dt == 0) o0 = __builtin_amdgcn_mfma_f32_32x32x16_bf16(avv, pbv, o0, 0, 0, 0);
                            else o1 = __builtin_amdgcn_mfma_f32_32x32x16_bf16(avv, pbv, o1, 0, 0, 0);
                        }
                    }
            }
        }
#ifdef ABL_SYNC2
        __syncthreads();
#endif
    }
    __syncthreads();
}
__device__ __forceinline__ void load_q(bf16x8 (&qf)[4], const bf16_t* qrow, int hi) {
#pragma unroll
    for (int s = 0; s < 4; ++s) qf[s] = *(const bf16x8*)(qrow + 16 * s + 8 * hi);
}
__device__ __forceinline__ float gain_bound(const float* gq, const float* gk, int lane) {
#ifdef ABL_CONSTM
    return 12.5f;
#endif
    const float mq = wave_max(fabsf(gq[lane])), mk = wave_max(fabsf(gk[lane]));
    return 8.f * mq * mk * LOG2E * 1.02f + 0.05f;
}
__device__ __forceinline__ void zero16(f32x16& v) {
#pragma unroll
    for (int r = 0; r < 16; ++r) v[r] = 0.f;
}

__device__ __forceinline__ void dil_unit(const Params& p, lds_t lds, int l, int unit) {
    const int tid = otid(), wave = __builtin_amdgcn_readfirstlane(tid >> 6), lane = tid & 63, r32 = lane & 31, hi = lane >> 5;
    const int bb = unit / 768, u2 = unit - bb * 768, hd = u2 >> 5, pb = u2 & 31, gi = hd >> 3, shift = 2 * gi, L = S >> shift, bh = bb * 24 + hd;
    const bf16_t* Q = (const bf16_t*)(p.ws + O_QA) + (size_t)bh * S * 64; const bf16_t* K = (const bf16_t*)(p.ws + O_KA) + (size_t)bh * S * 64; const bf16_t* V = (const bf16_t*)(p.ws + O_VA) + (size_t)bh * S * 64;
#ifdef ABL_KQ
    K = Q; V = Q;
#endif
#ifdef ABL_KQ2
    V = K;
#endif
    const int pbase = pb * 256, cs = (pbase / L) * L;
    int lo = pbase - 128; if (lo < cs) lo = cs;
#ifdef ABL_NONEIGH
    lo = pbase;
#endif
    const float negM = -gain_bound(p.a_q_g + l * 64, p.a_k_g + l * 64, lane);
    AP ap; ap.qpos = pbase + 32 * wave + r32; ap.wlo = pbase + 32 * wave; ap.whi = ap.wlo + 31; ap.m0 = ap.m1 = ap.m2 = ap.m3 = 0; ap.cur = 0; ap.inv = 0.f; ap.tokl = 0;
    bf16x8 qf[4]; load_q(qf, Q + (size_t)ap.qpos * 64, hi);
    f32x16 o0, o1; zero16(o0); zero16(o1); float lsum = 0.f;
#ifdef ABL_DIL_Q
#pragma unroll
    for (int r = 0; r < 16; ++r) { o0[r] = bf2f((unsigned short)qf[r & 3][r >> 2]); o1[r] = bf2f((unsigned short)qf[r & 3][4 + (r >> 2)]); }
    lsum = 1.f + 0.01f * (float)r32;
#else
    attn_tiles<0>(lds, K, V, lo >> 6, (pbase + 255) >> 6, qf, negM, o0, o1, lsum, ap);
#endif
#ifdef ABL_DISCARD
    { float* scr = (float*)(p.ws + O_ENDMIX) + ((size_t)unit * 512 + tid) * 36;
#pragma unroll
    for (int r = 0; r < 16; ++r) { scr[r] = o0[r]; scr[16 + r] = o1[r]; o0[r] = bf2f((unsigned short)qf[r & 3][r >> 2]); o1[r] = bf2f((unsigned short)qf[r & 3][4 + (r >> 2)]); }
    scr[32] = lsum; lsum = 1.f + 0.01f * (float)r32; }
#endif
    lsum = xhalf_sum(lsum);
#ifdef ABL_INV1
    const float inv = 30.f;
#else
    const float inv = 1.f / lsum;
#endif
    const int qp = ap.qpos;
    bf16_t* op = (bf16_t*)(p.ws + O_QA) + ((size_t)bh * S + qp) * 64 + 4 * hi;
#pragma unroll
    for (int rb = 0; rb < 4; ++rb) {
        u32x2 w; w.x = cvt_pk_bf16(o0[4 * rb] * inv, o0[4 * rb + 1] * inv); w.y = cvt_pk_bf16(o0[4 * rb + 2] * inv, o0[4 * rb + 3] * inv); *(u32x2*)(op + 8 * rb) = w;
        w.x = cvt_pk_bf16(o1[4 * rb] * inv, o1[4 * rb + 1] * inv); w.y = cvt_pk_bf16(o1[4 * rb + 2] * inv, o1[4 * rb + 3] * inv); *(u32x2*)(op + 32 + 8 * rb) = w;
    }
    if (hi == 0) ((float*)(p.ws + O_LSE))[(size_t)bh * S + qp] = (__log2f(lsum) - negM) * LN2;
}

__device__ __forceinline__ void cmp2_task(const Params& p, int l, int task, int lane) {
    const int bb = task >> 11, idx = (task >> 9) & 3, c = task & 511, kv = idx >> 1, kvh = idx & 1;
    bf16_t* dst = (bf16_t*)(p.ws + (kv ? O_VC : O_KC)) + ((size_t)(bb * 2 + kvh) * 512 + c) * 64;
    if (c == 511) { dst[lane] = 0; return; }
    const bf16_t* hid = (const bf16_t*)(p.ws + O_HID) + ((size_t)(bb * 4 + idx) * 512 + c) * 256;
    const float* w2 = p.cmp_w2 + (size_t)(l * 2 + kv) * 256 * 64 + lane;
    float s0 = 0.f, s1 = 0.f, s2 = 0.f, s3 = 0.f;
#pragma unroll 4
    for (int k = 0; k < 256; k += 4) { s0 += bf2f(hid[k]) * w2[(size_t)k * 64]; s1 += bf2f(hid[k + 1]) * w2[(size_t)(k + 1) * 64]; s2 += bf2f(hid[k + 2]) * w2[(size_t)(k + 2) * 64]; s3 += bf2f(hid[k + 3]) * w2[(size_t)(k + 3) * 64]; }
    float s = (s0 + s1) + (s2 + s3);
    if (kv == 0) {
        const float ss = wave_sum(s * s);
        const float y = s * rsqrtf(ss * (1.f / 64.f) + EPS) * p.b_k_g[(size_t)l * 192 + lane];
        const float other = __shfl_xor(y, 32);
        const float2 cs = ((const float2*)(p.ws + O_ROPE))[(size_t)(16 * c + 31) * 32 + (lane & 31)];
        s = lane < 32 ? (y * cs.x - other * cs.y) : (y * cs.x + other * cs.y);
    }
    const unsigned w = cvt_pk_bf16(s, 0.f);
    dst[lane] = (unsigned short)(w & 0xffff);
}

__device__ __forceinline__ void nsa_unit(const Params& p, lds_t lds, int l, int unit) {
    const int tid = otid(), wave = __builtin_amdgcn_readfirstlane(tid >> 6), lane = tid & 63, r32 = lane & 31, hi = lane >> 5;
    const int kvh = unit & 1, bb = (unit >> 1) & 1, tb = unit >> 2, t0 = tb * 64, cur = tb, bk = bb * 2 + kvh;
    {
        const int tok = tid >> 3, ch = tid & 7, t = t0 + tok, j = 4 * kvh + (ch >> 1), c0 = j * 64 + (ch & 1) * 32;
        const float* lse = (const float*)(p.ws + O_LSE);
        const size_t r0 = (size_t)(bb * 24 + j) * S + t, r1 = (size_t)(bb * 24 + 8 + j) * S + (size_t)(t & 3) * (S >> 2) + (t >> 2), r2 = (size_t)(bb * 24 + 16 + j) * S + (size_t)(t & 15) * (S >> 4) + (t >> 4);
        const float l0 = lse[r0], l1 = lse[r1], l2 = lse[r2];
        const float mx = fmaxf(l0, fmaxf(l1, l2)); float w0 = __expf(l0 - mx), w1 = __expf(l1 - mx), w2 = __expf(l2 - mx); const float is = 1.f / (w0 + w1 + w2); w0 *= is; w1 *= is; w2 *= is;
        const bf16_t* oa = (const bf16_t*)(p.ws + O_QA) + (ch & 1) * 32; bf16_t* out = (bf16_t*)(p.ws + O_OUTA) + ((size_t)bb * S + t) * 1024 + c0;
#pragma unroll
        for (int q = 0; q < 4; ++q) {
            const u32x4 a = *(const u32x4*)(oa + r0 * 64 + 8 * q), b = *(const u32x4*)(oa + r1 * 64 + 8 * q), c = *(const u32x4*)(oa + r2 * 64 + 8 * q);
            u32x4 o;
            o.x = cvt_pk_bf16(w0 * bflo(a.x) + w1 * bflo(b.x) + w2 * bflo(c.x), w0 * bfhi(a.x) + w1 * bfhi(b.x) + w2 * bfhi(c.x));
            o.y = cvt_pk_bf16(w0 * bflo(a.y) + w1 * bflo(b.y) + w2 * bflo(c.y), w0 * bfhi(a.y) + w1 * bfhi(b.y) + w2 * bfhi(c.y));
            o.z = cvt_pk_bf16(w0 * bflo(a.z) + w1 * bflo(b.z) + w2 * bflo(c.z), w0 * bfhi(a.z) + w1 * bfhi(b.z) + w2 * bfhi(c.z));
            o.w = cvt_pk_bf16(w0 * bflo(a.w) + w1 * bflo(b.w) + w2 * bflo(c.w), w0 * bfhi(a.w) + w1 * bfhi(b.w) + w2 * bfhi(c.w));
#ifdef ABL_CONST_OUTA
            { const float f0 = 0.01f * (float)((c0 + 8 * q) % 7) + 0.001f * (float)(t % 5); o.x = cvt_pk_bf16(f0, -f0); o.y = cvt_pk_bf16(f0 * 2.f, f0); o.z = o.x; o.w = o.y; }
#endif
            *(u32x4*)(out + 8 * q) = o;
        }
    }
    const int tokl = 8 * wave + (r32 >> 2), g = r32 & 3, t = t0 + tokl;
    const bf16_t* Q = (const bf16_t*)(p.ws + O_QB) + (((size_t)bk * S + t) * 4 + g) * 64;
    bf16x8 qf[4]; load_q(qf, Q, hi);
    const float* gate = (const float*)(p.ws + O_GATE) + ((size_t)bb * S + t) * 24 + kvh * 4 + g;
    float g_cmp = gate[0], g_sel = gate[8], g_win = gate[16];
#ifdef ABL_NO_CMP
    g_cmp = 0.f;
#endif
#ifdef ABL_NO_SEL
    g_sel = 0.f;
#endif
#ifdef ABL_NO_WIN
    g_win = 0.f;
#endif
    LAS float* slc = (LAS float*)(lds + LDS_SLC); LAS unsigned* maskw = (LAS unsigned*)(lds + LDS_MASK);
    for (int i = tid; i < 64 * 129; i += NTHREADS) slc[i] = 0.f;
    __syncthreads();
    f32x16 acc0, acc1; zero16(acc0); zero16(acc1);
    AP ap; ap.m0 = ap.m1 = ap.m2 = ap.m3 = 0; ap.cur = cur; ap.tokl = tokl; ap.inv = 0.f; ap.wlo = 0;
    {
        const bf16_t* K = (const bf16_t*)(p.ws + O_KC) + (size_t)bk * 512 * 64; const bf16_t* V = (const bf16_t*)(p.ws + O_VC) + (size_t)bk * 512 * 64;
        const float negM = -gain_bound(p.b_q_g + l * 64, p.b_k_g + (size_t)l * 192, lane);
        const int cmax_u = (t0 + 63 - 31) >> 4;
        ap.qpos = (t - 31) >> 4; ap.whi = (t0 + 8 * wave + 7 - 31) >> 4;
        if (cmax_u >= 0) {
            const int thi = cmax_u >> 6;
            f32x16 o0, o1; zero16(o0); zero16(o1); float l1 = 0.f, l2 = 0.f;
            attn_tiles<1>(lds, K, V, 0, thi, qf, negM, o0, o1, l1, ap);
            l1 = xhalf_sum(l1);
            ap.inv = l1 > 0.f ? 1.f / l1 : 0.f;
            attn_tiles<2>(lds, K, V, 0, thi, qf, negM, o0, o1, l2, ap);
#pragma unroll
            for (int r = 0; r < 16; ++r) { acc0[r] = g_cmp * o0[r]; acc1[r] = g_cmp * o1[r]; }
        }
    }
    __syncthreads();
    if (wave == 0) {
        unsigned m0 = 0, m1 = 0, m2 = 0, m3 = 0;
        if (cur < 16) { m0 = (2u << cur) - 1u; }
        else {
            float top[13];
#pragma unroll
            for (int i = 0; i < 13; ++i) top[i] = -2.f;
            const LAS float* sr = slc + lane * 129;
            for (int b = 1; b <= cur - 2; ++b) { float v = sr[b];
#pragma unroll
                for (int i = 0; i < 13; ++i) { const float hi_ = fmaxf(top[i], v); v = fminf(top[i], v); top[i] = hi_; } }
            const float thr = top[12]; int ngt = 0;
            for (int b = 1; b <= cur - 2; ++b) ngt += sr[b] > thr ? 1 : 0;
            int need_eq = 13 - ngt;
            for (int b = 1; b <= cur - 2; ++b) { const float v = sr[b]; bool sel = v > thr; if (!sel && v == thr && need_eq > 0) { sel = true; --need_eq; }
                const unsigned bitv = sel ? (1u << (b & 31)) : 0u;
                if (b < 32) m0 |= bitv; else if (b < 64) m1 |= bitv; else if (b < 96) m2 |= bitv; else m3 |= bitv; }
            m0 |= 1u;
            { const int b = cur; const unsigned bv = 1u << (b & 31); if (b < 32) m0 |= bv; else if (b < 64) m1 |= bv; else if (b < 96) m2 |= bv; else m3 |= bv; }
            { const int b = cur - 1; const unsigned bv = 1u << (b & 31); if (b < 32) m0 |= bv; else if (b < 64) m1 |= bv; else if (b < 96) m2 |= bv; else m3 |= bv; }
        }
        maskw[lane * 4 + 0] = m0; maskw[lane * 4 + 1] = m1; maskw[lane * 4 + 2] = m2; maskw[lane * 4 + 3] = m3;
    }
    __syncthreads();
    ap.m0 = maskw[tokl * 4 + 0]; ap.m1 = maskw[tokl * 4 + 1]; ap.m2 = maskw[tokl * 4 + 2]; ap.m3 = maskw[tokl * 4 + 3];
    ap.qpos = t;
    {
        const bf16_t* K = (const bf16_t*)(p.ws + O_KS) + (size_t)bk * SP * 64; const bf16_t* V = (const bf16_t*)(p.ws + O_VS) + (size_t)bk * SP * 64;
        const float negM = -gain_bound(p.b_q_g + l * 64, p.b_k_g + (size_t)l * 192 + 64, lane);
        f32x16 o0, o1; zero16(o0); zero16(o1); float ls = 0.f;
        attn_tiles<3>(lds, K, V, 0, cur, qf, negM, o0, o1, ls, ap);
        ls = xhalf_sum(ls);
        const float sc = g_sel / ls;
#pragma unroll
        for (int r = 0; r < 16; ++r) { acc0[r] += sc * o0[r]; acc1[r] += sc * o1[r]; }
    }
    {
        const bf16_t* K = (const bf16_t*)(p.ws + O_KW) + (size_t)bk * SP * 64; const bf16_t* V = (const bf16_t*)(p.ws + O_VW) + (size_t)bk * SP * 64;
        const float negM = -gain_bound(p.b_q_g + l * 64, p.b_k_g + (size_t)l * 192 + 128, lane);
        f32x16 o0, o1; zero16(o0); zero16(o1); float ls = 0.f;
        attn_tiles<4>(lds, K, V, cur >= 8 ? cur - 8 : 0, cur, qf, negM, o0, o1, ls, ap);
        ls = xhalf_sum(ls);
        const float sc = g_win / ls;
#pragma unroll
        for (int r = 0; r < 16; ++r) { acc0[r] += sc * o0[r]; acc1[r] += sc * o1[r]; }
    }
    bf16_t* op = (bf16_t*)(p.ws + O_OUTA) + ((size_t)bb * S + t) * 1024 + 512 + (kvh * 4 + g) * 64 + 4 * hi;
#pragma unroll
    for (int rb = 0; rb < 4; ++rb) {
        u32x2 w; w.x = cvt_pk_bf16(acc0[4 * rb], acc0[4 * rb + 1]); w.y = cvt_pk_bf16(acc0[4 * rb + 2], acc0[4 * rb + 3]); *(u32x2*)(op + 8 * rb) = w;
        w.x = cvt_pk_bf16(acc1[4 * rb], acc1[4 * rb + 1]); w.y = cvt_pk_bf16(acc1[4 * rb + 2], acc1[4 * rb + 3]); *(u32x2*)(op + 32 + 8 * rb) = w;
    }
    __syncthreads();
}

__device__ __forceinline__ void phase_conv(const Params& p, int l) {
    bf16_t* act = (bf16_t*)(p.ws + O_ACT); const float* gh = (const float*)(p.ws + O_GH); const float* g0 = (const float*)(p.ws + O_G0); const float* u0 = (const float*)(p.ws + O_U0);
    const float* cw = p.conv_w + (size_t)l * 3 * DFF; const float* cb = p.conv_b + (size_t)l * DFF;
    constexpr int NCH4 = DFF / 4, NGRP = MT / 64;
    for (int it = blockIdx.x * NTHREADS + otid(); it < NCH4 * NGRP; it += gridDim.x * NTHREADS) {
        const int ch = it % NCH4, grp = it / NCH4, c = ch * 4;
        const bool first = (grp & (S / 64 - 1)) == 0;
        const f32x4 z4 = {0.f, 0.f, 0.f, 0.f};
        const f32x4 w0 = *(const f32x4*)(cw + c), w1 = *(const f32x4*)(cw + DFF + c), w2 = *(const f32x4*)(cw + 2 * DFF + c), bb = *(const f32x4*)(cb + c);
        const f32x4 q2 = first ? z4 : *(const f32x4*)(gh + ((size_t)(grp - (first ? 0 : 1)) * 2 + 0) * DFF + c), q1 = first ? z4 : *(const f32x4*)(gh + ((size_t)(grp - (first ? 0 : 1)) * 2 + 1) * DFF + c);
        const f32x4 ga = *(const f32x4*)(g0 + ((size_t)grp * 2 + 0) * DFF + c), gb = *(const f32x4*)(g0 + ((size_t)grp * 2 + 1) * DFF + c);
        const f32x4 ua = *(const f32x4*)(u0 + ((size_t)grp * 2 + 0) * DFF + c), ub = *(const f32x4*)(u0 + ((size_t)grp * 2 + 1) * DFF + c);
        f32x4 oa, ob;
#pragma unroll
        for (int e = 0; e < 4; ++e) { const float za = bb[e] + w0[e] * q2[e] + w1[e] * q1[e] + w2[e] * ga[e]; oa[e] = za * sigmoidf_(za) * ua[e];
            const float zb = bb[e] + w0[e] * q1[e] + w1[e] * ga[e] + w2[e] * gb[e]; ob[e] = zb * sigmoidf_(zb) * ub[e]; }
        u32x2 w; w.x = cvt_pk_bf16(oa[0], oa[1]); w.y = cvt_pk_bf16(oa[2], oa[3]); *(u32x2*)(act + ((size_t)grp * 64 + 0) * DFF + c) = w;
        w.x = cvt_pk_bf16(ob[0], ob[1]); w.y = cvt_pk_bf16(ob[2], ob[3]); *(u32x2*)(act + ((size_t)grp * 64 + 1) * DFF + c) = w;
    }
}

#ifndef PHEN
#define PHEN 0xFFFF
#endif
#define EN(n) (((PHEN) >> (n)) & 1)
__device__ __forceinline__ void my_grid_bar(unsigned* bar) {
    asm volatile("s_waitcnt vmcnt(0) lgkmcnt(0)" ::: "memory");
    __syncthreads();
    if (threadIdx.x == 0) {
        const unsigned G = gridDim.x;
        __builtin_amdgcn_fence(__ATOMIC_RELEASE, "agent");
        asm volatile("s_waitcnt vmcnt(0)" ::: "memory");
        const unsigned g0 = __hip_atomic_load(bar + 64, __ATOMIC_RELAXED, __HIP_MEMORY_SCOPE_AGENT);
        const unsigned old = __hip_atomic_fetch_add(bar, 1u, __ATOMIC_RELAXED, __HIP_MEMORY_SCOPE_AGENT);
        const unsigned base = (old >= 0xAAAAAAAAu && old - 0xAAAAAAAAu < G) ? 0xAAAAAAAAu : 0u;
        if (old - base == G - 1u) { __hip_atomic_store(bar, 0u, __ATOMIC_RELAXED, __HIP_MEMORY_SCOPE_AGENT); (void)__hip_atomic_fetch_add(bar + 64, 1u, __ATOMIC_RELEASE, __HIP_MEMORY_SCOPE_AGENT); }
        else while (__hip_atomic_load(bar + 64, __ATOMIC_RELAXED, __HIP_MEMORY_SCOPE_AGENT) == g0) __builtin_amdgcn_s_sleep(2);
        __builtin_amdgcn_fence(__ATOMIC_ACQUIRE, "agent");
        asm volatile("s_waitcnt vmcnt(0)" ::: "memory");
    }
    __syncthreads();
}
#define XB_TMO      128
#define XB_XCNT(j)  (256  + 64 * (j))
#define XB_XSUB(j)  (1280 + 64 * (j))
#define XB_XGEN(j)  (2304 + 64 * (j))
#define XB_TOP      3328
#define XB_TOPGEN   3392
#define XCD_BAR_WORDS 3456
#define XB_SPIN_CAP (1u << 18)

__device__ __forceinline__ unsigned xb_ld(unsigned* p)              { return __hip_atomic_load(p, __ATOMIC_RELAXED, __HIP_MEMORY_SCOPE_AGENT); }
__device__ __forceinline__ unsigned xb_add(unsigned* p, unsigned v) { return __hip_atomic_fetch_add(p, v, __ATOMIC_RELAXED, __HIP_MEMORY_SCOPE_AGENT); }
__device__ __forceinline__ unsigned xb_xcc_id() { return (unsigned)__builtin_amdgcn_s_getreg((3 << 11) | 20) & 0xFu; }
#define XB_SPIN(cond, bar) do { unsigned _sp = 0; while (cond) { __builtin_amdgcn_s_sleep(1); \
    if ((++_sp & 255u) == 0u) { if (xb_ld(&(bar)[XB_TMO])) break; if (_sp > XB_SPIN_CAP) { atomicAdd(&(bar)[XB_TMO], 1u); break; } } } } while (0)

struct XcdBarrier {
    unsigned* bar; unsigned x;
    volatile LAS unsigned* st;
};

__device__ __forceinline__ XcdBarrier xcd_barrier_post(unsigned* bar, volatile LAS unsigned* st) {
    XcdBarrier b; b.bar = bar; b.x = xb_xcc_id(); b.st = st;
    if (threadIdx.x == 0) (void)xb_add(&bar[XB_XCNT(b.x)], 1u);
    return b;
}
__device__ __forceinline__ void xcd_barrier_complete(unsigned* bar, unsigned x, unsigned& nloc, unsigned& nx) {
    const unsigned G = gridDim.x * gridDim.y * gridDim.z;
    unsigned sum, cnt, mine, sp = 0u;
    for (;;) {
        sum = 0u; cnt = 0u; mine = 0u;
#pragma unroll
        for (unsigned j = 0; j < 16; ++j) { const unsigned c = xb_ld(&bar[XB_XCNT(j)]); sum += c; cnt += (c > 0u) ? 1u : 0u; mine = (j == x) ? c : mine; }
        if (sum == G) break;
        __builtin_amdgcn_s_sleep(1);
        if ((++sp & 255u) == 0u) { if (xb_ld(&bar[XB_TMO])) break; if (sp > XB_SPIN_CAP) { atomicAdd(&bar[XB_TMO], 1u); break; } }
    }
    nloc = mine > 0u ? mine : 1u; nx = cnt > 0u ? cnt : 1u;
}

__device__ __forceinline__ void xcd_barrier(const XcdBarrier& b) {
    asm volatile("s_waitcnt vmcnt(0)" ::: "memory");
    __syncthreads();
    if (threadIdx.x == 0) {
        unsigned* bar = b.bar;
        __builtin_amdgcn_s_waitcnt(0);
        unsigned nloc = b.st[0], nx = b.st[1];
        if (nloc == 0u) { xcd_barrier_complete(bar, b.x, nloc, nx); b.st[0] = nloc; b.st[1] = nx; }
        const unsigned old = xb_add(&bar[XB_XSUB(b.x)], 1u);
        const unsigned gen = old / nloc;
        if (old + 1u == (gen + 1u) * nloc) {
            __builtin_amdgcn_fence(__ATOMIC_RELEASE, "agent");
            asm volatile("s_waitcnt vmcnt(0)" ::: "memory");
            const unsigned og = xb_add(&bar[XB_TOP], 1u);
            const unsigned tg = og / nx;
            if (og + 1u == (tg + 1u) * nx) xb_add(&bar[XB_TOPGEN], 1u);
            else XB_SPIN(xb_ld(&bar[XB_TOPGEN]) == tg, bar);
            __builtin_amdgcn_fence(__ATOMIC_ACQUIRE, "agent");
            xb_add(&bar[XB_XGEN(b.x)], 1u);
            asm volatile("s_waitcnt vmcnt(0)" ::: "memory");
        } else {
            XB_SPIN(xb_ld(&bar[XB_XGEN(b.x)]) == gen, bar);
            __builtin_amdgcn_fence(__ATOMIC_ACQUIRE, "agent");
            asm volatile("s_waitcnt vmcnt(0)" ::: "memory");
        }
    }
    __syncthreads();
}
constexpr int STEPS = 9, PER_PASS = 1 + DEPTH * STEPS, NPHASES = 1 + NPASS * PER_PASS;

__global__ void __launch_bounds__(NTHREADS, 2) mega_fwd(Params p) {
    extern __shared__ __attribute__((aligned(16))) unsigned char lds_raw[];
    lds_t lds = (lds_t)lds_raw;
    cg::grid_group grid = cg::this_grid();
    const int G = gridDim.x;
    volatile LAS unsigned* xst = (volatile LAS unsigned*)(lds + 131072);
    if (threadIdx.x == 0) { xst[0] = 0u; xst[1] = 0u; }
    __syncthreads();
    const XcdBarrier xbar = xcd_barrier_post((unsigned*)(p.ws + O_BAR), xst);
#pragma nounroll
    for (int ph = p.ph_lo; ph < p.ph_hi; ++ph) {
        int c = blockIdx.x; asm volatile("" : "+s"(c));
        const int tid = otid(), wave = tid >> 6, lane = tid & 63;
        if (ph == 0) phase_prologue(p, lds);
        else {
            const int q = ph - 1, b = q / PER_PASS, r = q % PER_PASS;
            if (r == 0) phase_x0(p, b);
            else {
                const int l = (r - 1) / STEPS, st = (r - 1) % STEPS;
                unsigned char* ws = p.ws;
                float* xout = p.out + (size_t)b * MT * DM;
                if (st == 0) {
                    Gemm g{(const bf16_t*)(ws + O_XB), (const bf16_t*)(ws + O_WIN + l * SZ_WIN), MT, NINP, DM, DM};
                    StaticOrder so; so.init(MT, NINP, G, c);
                    EpiIn e{(const float*)(ws + O_RS1), (const float2*)(ws + O_ROPE), p.a_q_g + l * 64, p.a_k_g + l * 64, p.b_q_g + l * 64, p.b_k_g + (size_t)l * 192, ws};
                    pg8::gemm_phase<EpiIn, StaticOrder, true, true>(lds, g, so, e);
#ifdef PROBE_IN2
                    pg8::gemm_phase<EpiIn, StaticOrder, true, true>(lds, g, so, e);
#endif
                } else if (st == 1 || st == 2) {
                    if (st == 1) {
#pragma unroll 1
                        for (int idx = 0; idx < 4 * NB; ++idx) { const int bb = idx >> 2, kv = (idx >> 1) & 1, kvh = idx & 1;
                            Gemm g{(const bf16_t*)(ws + (kv ? O_VCR : O_KCR)) + (size_t)(bb * 2 + kvh) * SP * 64, (const bf16_t*)(ws + O_WC1 + (size_t)(l * 2 + kv) * SZ_WC1), 512, 256, 2048, 1024};
                            StaticOrder so; so.init(512, 256, G, (c + G - 2 * idx) % G);
                            EpiGelu e{(bf16_t*)(ws + O_HID) + (size_t)idx * 512 * 256, (const float*)(ws + O_POSB) + (l * 2 + kv) * 256};
                            pg8::gemm_phase<EpiGelu, StaticOrder, true, true>(lds, g, so, e);
                        }
                    } else {
                        for (int task = c * 8 + wave; task < NB * 2048; task += G * 8) cmp2_task(p, l, task, lane);
                    }
                    constexpr int HALF_U = NB * 768 / 2;
                    const int u0 = st == 1 ? 0 : HALF_U;
                    if (st == 1) {
                        unsigned* ctr = (unsigned*)(ws + O_BAR) + 3600 + (b * DEPTH + l);
                        volatile LAS unsigned* slot = (volatile LAS unsigned*)(lds + 131072 + 8);
                        for (;;) {
                            __syncthreads();
                            if (threadIdx.x == 0) slot[0] = __hip_atomic_fetch_add(ctr, 1u, __ATOMIC_RELAXED, __HIP_MEMORY_SCOPE_AGENT);
                            __syncthreads();
                            const int u = (int)slot[0];
                            if (u >= HALF_U) break;
                            dil_unit(p, lds, l, u);
                        }
                    } else
                    for (int u = u0 + c; u < u0 + HALF_U; u += G) dil_unit(p, lds, l, u);
                } else if (st == 3) {
                    constexpr int NU = NB * 256;
                    for (int u = c; u < NU / 2; u += G) { nsa_unit(p, lds, l, NU - 1 - u); nsa_unit(p, lds, l, u); }
#ifdef PROBE_NSA2
                    for (int u = c; u < NU / 2; u += G) { nsa_unit(p, lds, l, NU - 1 - u); nsa_unit(p, lds, l, u); }
#endif
                } else if (st == 4) {
                    { Gemm g{(const bf16_t*)(ws + O_OUTA), (const bf16_t*)(ws + O_WPA + l * 2 * SZ_WP), MT, DM, 1024, 1024};
                      StaticOrder so; so.init(MT, DM, G, c); EpiProjF e{(bf16_t*)(ws + O_MIXED), (const bf16_t*)(ws + O_MG)};
                      pg8::gemm_phase<EpiProjF, StaticOrder, true, true>(lds, g, so, e); }
                } else if (st == 5) {
                    Gemm g{(const bf16_t*)(ws + O_MIXED), (const bf16_t*)(ws + O_WOUT + l * SZ_WOUT), MT, DM, DM, DM};
                    StaticOrder so; so.init(MT, DM, G, c);
                    EpiRes e{nullptr, (bf16_t*)(ws + O_XB), (float*)(ws + O_RS2)};
                    pg8::gemm_phase<EpiRes, StaticOrder, true, true>(lds, g, so, e);
                } else if (st == 6) {
                    Gemm g{(const bf16_t*)(ws + O_XB), (const bf16_t*)(ws + O_WUP + l * SZ_WUP), MT, NUP, DM, DM};
                    StaticOrder so; so.init(MT, NUP, G, c);
                    EpiUpConv e{(bf16_t*)(ws + O_ACT), (const float*)(ws + O_RS2), p.conv_w + (size_t)l * 3 * DFF, p.conv_b + (size_t)l * DFF, (float*)(ws + O_GH), (float*)(ws + O_G0), (float*)(ws + O_U0)};
                    pg8::gemm_phase<EpiUpConv, StaticOrder, true, true>(lds, g, so, e);
                } else if (st == 7) {
                    phase_conv(p, l);
                } else {
                    Gemm g{(const bf16_t*)(ws + O_ACT), (const bf16_t*)(ws + O_WDN + l * SZ_WDN), MT, DM, DFF, DFF};
                    StaticOrder so; so.init(MT, DM, G, c);
                    EpiRes e{l == DEPTH - 1 ? xout : nullptr, (bf16_t*)(ws + O_XB), (float*)(ws + O_RS1)};
                    pg8::gemm_phase<EpiRes, StaticOrder, true, true>(lds, g, so, e);
                }
            }
        }
        if (ph + 1 < p.ph_hi) { xcd_barrier(xbar); if (ph == 0) grid.sync(); }
    }
}

extern "C" void kernel_launch(void* const* d_in, const int* in_sizes, int n_in, void* d_out, int out_size, void* d_ws, size_t ws_size, hipStream_t stream) {
    static int grid = 0;
    if (grid == 0) {
        if (ws_size < WS_NEED) { fprintf(stderr, "kernel_launch: workspace too small: %zu < %zu\n", ws_size, (size_t)WS_NEED); grid = -1; return; }
        int dev = 0, cus = 0, per_cu = 0;
        (void)hipGetDevice(&dev); (void)hipDeviceGetAttribute(&cus, hipDeviceAttributeMultiprocessorCount, dev);
        if (hipFuncSetAttribute((const void*)mega_fwd, hipFuncAttributeMaxDynamicSharedMemorySize, LDS_BYTES) != hipSuccess) { fprintf(stderr, "hipFuncSetAttribute failed\n"); grid = -1; return; }
        (void)hipOccupancyMaxActiveBlocksPerMultiprocessor(&per_cu, (const void*)mega_fwd, NTHREADS, LDS_BYTES);
        (void)hipGetLastError();
        if (per_cu < 1) per_cu = 1;
        grid = cus;
    }
    if (grid < 0) return;
    (void)hipMemsetAsync(d_ws, 0, 16384, stream);
    Params p{};
    const float** pp = (const float**)&p;
    for (int i = 0; i < 18; ++i) pp[i] = (const float*)d_in[i];
    p.out = (float*)d_out; p.ws = (unsigned char*)d_ws;
#ifdef MULTI_LAUNCH
    for (int ph = 0; ph < NPHASES; ++ph) { p.ph_lo = ph; p.ph_hi = ph + 1; hipLaunchKernelGGL(mega_fwd, dim3(grid), dim3(NTHREADS), LDS_BYTES, stream, p); }
#else
    p.ph_lo = 0; p.ph_hi = NPHASES;
    void* args[] = {&p};
    hipError_t e = hipLaunchCooperativeKernel((const void*)mega_fwd, dim3(grid), dim3(NTHREADS), args, LDS_BYTES, stream);
    if (e != hipSuccess) fprintf(stderr, "cooperative launch failed: %s (grid %d)\n", hipGetErrorString(e), grid);
#endif
}
```

```cpp
#include <hip/hip_runtime.h>
#include <hip/hip_cooperative_groups.h>
#include <cstdio>
#include <cstdint>
#include <type_traits>
namespace cg = cooperative_groups;
__device__ __forceinline__ int otid() { int t = threadIdx.x; asm volatile("" : "+v"(t)); return t; }
namespace pg8 {
#define PG8_LAS __attribute__((address_space(3)))
typedef unsigned short bf16_t;
typedef short bf16x8 __attribute__((ext_vector_type(8)));
typedef float f32x4 __attribute__((ext_vector_type(4)));
typedef unsigned u32x4 __attribute__((ext_vector_type(4)));
constexpr int BM = 256, BK = 64, HALF = 128, HTB = HALF * BK * 2  , STAGE_BYTES = 8 * HTB, NXCD = 8, WGM = 8;

__host__ __device__ __forceinline__ int lds_byte(int r, int c) { const int st = (r >> 4) * 2 + (c >> 5), rr = r & 15, cc = c & 31, ob = rr * 64 + cc * 2; return st * 1024 + (ob ^ (((ob >> 9) & 1) << 5)); }
__host__ __device__ __forceinline__ void stage_rc(int b, int& R, int& C) { const int st = b / 1024, sb = b % 1024, swz = sb ^ (((sb >> 9) & 1) << 5); R = (st >> 1) * 16 + swz / 64; C = (st & 1) * 32 + (swz % 64) / 2; }
__host__ __device__ __forceinline__ int perm32(int rho) { const int n = rho >> 4, i = rho & 15; return 8 * (i >> 2) + 4 * n + (i & 3); }

struct Unit { int pm, pn; };
struct Gemm { const bf16_t* A; const bf16_t* Bt; int M, N, K, lda; };

struct StaticOrder {
    int nM, nN, nwg, G, c;
    __host__ __device__ void init(int M, int N, int G_, int c_) { nM = M / BM; nN = N / BM; nwg = nM * nN; G = G_; c = c_; }
    __host__ __device__ bool next(int i, Unit& u) const {
        const long L = (long)i * G + c; if (L >= nwg) return false;
        int wgid = (int)L; { const int q = nwg / NXCD, r = nwg % NXCD, xcd = wgid % NXCD, off = wgid / NXCD; wgid = (xcd < r ? xcd * (q + 1) : r * (q + 1) + (xcd - r) * q) + off; }
        const int nig = WGM * nN, gid = wgid / nig, fm = gid * WGM, gsz = (nM - fm) < WGM ? (nM - fm) : WGM;
        u.pm = fm + ((wgid % nig) % gsz); u.pn = (wgid % nig) / gsz; return true;
    }
    __device__ __forceinline__ void a_ready(const Unit&) const {}
    __device__ __forceinline__ void done(const Unit&) const {}
};

typedef float cvt_f32x2_t __attribute__((ext_vector_type(2))); typedef __bf16 cvt_bf16x2_t __attribute__((ext_vector_type(2)));
__device__ __forceinline__ unsigned cvt_pk_bf16(float lo, float hi) { cvt_f32x2_t v = {lo, hi}; cvt_bf16x2_t b = __builtin_convertvector(v, cvt_bf16x2_t); return __builtin_bit_cast(unsigned, b); }
template <class Epi, class Sched, bool ALIGN_EPI = false, bool SP2 = false>
__device__ __forceinline__ void gemm_phase(PG8_LAS unsigned char* lds, const Gemm g, const Sched& S, const Epi& E) {
    const int tid = otid(), wid = __builtin_amdgcn_readfirstlane(tid >> 6), lane = tid & 63, wr = wid >> 2, wc = wid & 3, fr = lane & 15, fq = lane >> 4;
    const int K = g.K, nt = K / BK;
    unsigned voffA[2], voffB[2];
#pragma unroll
    for (int i = 0; i < 2; ++i) { int R, C; stage_rc(tid * 16 + i * 8192, R, C); const int Rb = Epi::PERM ? ((R & ~31) + perm32(R & 31)) : R;
        voffA[i] = (unsigned)(R * g.lda + C) * 2u; voffB[i] = (unsigned)(Rb * K + C) * 2u; }
    const size_t kstep = (size_t)(BK * 2);
    const size_t hstepB = (size_t)HALF * K * 2, hstepA = (size_t)HALF * g.lda * 2;
    const size_t tstepA = 2 * hstepA, tstepB = 2 * hstepB;
    const unsigned ldsw = (unsigned)wid * 1024u;
    const int aoff = lds_byte(wr * 64 + fr, fq * 8), boff = lds_byte(wc * 32 + fr, fq * 8);
#define PG8_SA(b, h) (((b) * 2 + (h)) * HTB)
#define PG8_SB(b, h) ((4 + (b) * 2 + (h)) * HTB)
#define PG8_STAGE(bufoff, gbase, voff) do { _Pragma("unroll") for (int _i = 0; _i < 2; ++_i) \
        __builtin_amdgcn_global_load_lds((const unsigned*)((const char*)(gbase) + (voff)[_i]), (PG8_LAS unsigned*)(lds + (bufoff) + ldsw + _i * 8192), 16, 0, 0); } while (0)
#define PG8_LDA(dst, b, h) do { _Pragma("unroll") for (int m = 0; m < 4; ++m) _Pragma("unroll") for (int k = 0; k < 2; ++k) dst[m][k] = *(const PG8_LAS bf16x8*)(lds + PG8_SA(b, h) + aoff + m * 2048 + k * 1024); } while (0)
#define PG8_LDB(dst, b, h) do { _Pragma("unroll") for (int n = 0; n < 2; ++n) _Pragma("unroll") for (int k = 0; k < 2; ++k) dst[n][k] = *(const PG8_LAS bf16x8*)(lds + PG8_SB(b, h) + boff + n * 2048 + k * 1024); } while (0)
#define PG8_MMA(ai, bj, At, Bt) do { __builtin_amdgcn_s_setprio(1); _Pragma("unroll") for (int m = 0; m < 4; ++m) _Pragma("unroll") for (int n = 0; n < 2; ++n) _Pragma("unroll") for (int k = 0; k < 2; ++k) \
        acc[ai][bj][m][n] = __builtin_amdgcn_mfma_f32_16x16x32_bf16(Bt[n][k], At[m][k], acc[ai][bj][m][n], 0, 0, 0); __builtin_amdgcn_s_setprio(0); } while (0)
#define PG8_WAIT_V(n) asm volatile("s_waitcnt vmcnt(" #n ")" ::: "memory")
#define PG8_WAIT_L(n) asm volatile("s_waitcnt lgkmcnt(" #n ")" ::: "memory")
#define PG8_BAR __builtin_amdgcn_s_barrier()
#define PG8_SCHED __builtin_amdgcn_sched_barrier(0)
    Unit cur, nxt; int ui = 0;
    if (!S.next(0, cur)) return;
    f32x4 acc[2][2][4][2];
#pragma unroll
    for (int a = 0; a < 2; ++a)
#pragma unroll
        for (int b = 0; b < 2; ++b)
#pragma unroll
            for (int m = 0; m < 4; ++m)
#pragma unroll
                for (int n = 0; n < 2; ++n) acc[a][b][m][n] = (f32x4){0.f, 0.f, 0.f, 0.f};
    bf16x8 At[4][2], B0[2][2], B1[2][2];
    const char* cA = (const char*)g.A + (size_t)cur.pm * tstepA; const char* cB = (const char*)g.Bt + (size_t)cur.pn * tstepB;
    S.a_ready(cur);
    if constexpr (SP2) {
        PG8_STAGE(PG8_SB(0, 0), cB, voffB); PG8_STAGE(PG8_SB(0, 1), cB + hstepB, voffB); PG8_STAGE(PG8_SA(0, 0), cA, voffA); PG8_STAGE(PG8_SA(0, 1), cA + hstepA, voffA);
        if (wr == 1) PG8_BAR;
        PG8_WAIT_V(2); PG8_BAR;
        PG8_STAGE(PG8_SB(1, 0), cB + kstep, voffB); PG8_STAGE(PG8_SA(1, 0), cA + kstep, voffA); PG8_STAGE(PG8_SB(1, 1), cB + hstepB + kstep, voffB);
        PG8_WAIT_V(6); PG8_BAR;
    } else {
        PG8_STAGE(PG8_SB(0, 0), cB, voffB); PG8_STAGE(PG8_SA(0, 0), cA, voffA); PG8_STAGE(PG8_SB(0, 1), cB + hstepB, voffB); PG8_STAGE(PG8_SA(0, 1), cA + hstepA, voffA);
        if (wr == 1) PG8_BAR;
        PG8_WAIT_V(4); PG8_BAR;
        PG8_STAGE(PG8_SB(1, 0), cB + kstep, voffB); PG8_STAGE(PG8_SA(1, 0), cA + kstep, voffA); PG8_STAGE(PG8_SB(1, 1), cB + hstepB + kstep, voffB);
        PG8_WAIT_V(6); PG8_BAR;
    }
    for (;;) {
        const bool has_next = S.next(ui + 1, nxt);
        const char* nA = has_next ? (const char*)g.A + (size_t)nxt.pm * tstepA : cA; const char* nB = has_next ? (const char*)g.Bt + (size_t)nxt.pn * tstepB : cB;
        for (int t = 0; t < nt; t += 2) {
            if constexpr (Epi::HAS_MID) { if (t == (nt >> 1)) E.mid(acc, cur, wr, wc, fr, fq); }
            const bool last = (t == nt - 2);
            const char* a1 = cA + (size_t)(t + 1) * kstep;
            const char* a2 = last ? nA : cA + (size_t)(t + 2) * kstep; const char* b2 = last ? nB : cB + (size_t)(t + 2) * kstep;
            const char* a3 = a2 + kstep; const char* b3 = b2 + kstep;
            if (last && has_next) S.a_ready(nxt);
            if constexpr (SP2) {
            PG8_LDB(B0, 0, 0); PG8_LDB(B1, 0, 1); PG8_SCHED; PG8_LDA(At, 0, 0); PG8_STAGE(PG8_SA(1, 1), a1 + hstepA, voffA);
            PG8_WAIT_V(8); PG8_WAIT_L(0); PG8_BAR; PG8_MMA(0, 0, At, B0); PG8_MMA(0, 1, At, B1); PG8_BAR; PG8_SCHED;
            PG8_LDA(At, 0, 1); PG8_STAGE(PG8_SB(0, 0), b2, voffB); PG8_STAGE(PG8_SB(0, 1), b2 + hstepB, voffB); PG8_STAGE(PG8_SA(0, 0), a2, voffA);
            PG8_WAIT_V(8); PG8_WAIT_L(0); PG8_BAR; PG8_MMA(1, 0, At, B0); PG8_MMA(1, 1, At, B1); PG8_BAR; PG8_SCHED;
            PG8_LDB(B0, 1, 0); PG8_LDB(B1, 1, 1); PG8_SCHED; PG8_LDA(At, 1, 0); PG8_STAGE(PG8_SA(0, 1), a2 + hstepA, voffA);
            PG8_WAIT_V(8); PG8_WAIT_L(0); PG8_BAR; PG8_MMA(0, 0, At, B0); PG8_MMA(0, 1, At, B1); PG8_BAR; PG8_SCHED;
            PG8_LDA(At, 1, 1); PG8_STAGE(PG8_SB(1, 0), b3, voffB); PG8_STAGE(PG8_SB(1, 1), b3 + hstepB, voffB); PG8_STAGE(PG8_SA(1, 0), a3, voffA);
            PG8_WAIT_V(8); PG8_WAIT_L(0); PG8_BAR; PG8_MMA(1, 0, At, B0); PG8_MMA(1, 1, At, B1); PG8_BAR; PG8_SCHED;
            } else {
            PG8_LDB(B0, 0, 0); PG8_SCHED; PG8_LDA(At, 0, 0); PG8_STAGE(PG8_SA(1, 1), a1 + hstepA, voffA);
            PG8_WAIT_L(8); PG8_BAR; PG8_WAIT_L(0); PG8_MMA(0, 0, At, B0); PG8_BAR; PG8_SCHED;
            PG8_LDB(B1, 0, 1); PG8_STAGE(PG8_SB(0, 0), b2, voffB);
            PG8_BAR; PG8_WAIT_L(0); PG8_MMA(0, 1, At, B1); PG8_BAR;
            PG8_LDA(At, 0, 1); PG8_STAGE(PG8_SA(0, 0), a2, voffA);
            PG8_BAR; PG8_WAIT_L(0); PG8_MMA(1, 0, At, B0); PG8_BAR; PG8_SCHED;
            PG8_STAGE(PG8_SB(0, 1), b2 + hstepB, voffB);
            PG8_WAIT_V(6); PG8_BAR; PG8_MMA(1, 1, At, B1); PG8_BAR;
            PG8_LDB(B0, 1, 0); PG8_SCHED; PG8_LDA(At, 1, 0); PG8_STAGE(PG8_SA(0, 1), a2 + hstepA, voffA);
            PG8_WAIT_L(8); PG8_BAR; PG8_WAIT_L(0); PG8_MMA(0, 0, At, B0); PG8_BAR; PG8_SCHED;
            PG8_LDB(B1, 1, 1); PG8_STAGE(PG8_SB(1, 0), b3, voffB);
            PG8_BAR; PG8_WAIT_L(0); PG8_MMA(0, 1, At, B1); PG8_BAR;
            PG8_LDA(At, 1, 1); PG8_STAGE(PG8_SA(1, 0), a3, voffA);
            PG8_BAR; PG8_WAIT_L(0); PG8_MMA(1, 0, At, B0); PG8_BAR; PG8_SCHED;
            PG8_STAGE(PG8_SB(1, 1), b3 + hstepB, voffB);
            PG8_WAIT_V(6); PG8_BAR; PG8_MMA(1, 1, At, B1); PG8_BAR;
            }
        }
        if constexpr (ALIGN_EPI) { if (wr == 0) PG8_BAR; }
        if constexpr (!Epi::AFTER_DRAIN) { E(acc, cur, wr, wc, fr, fq); S.done(cur); }
        if (!has_next) break;
#pragma unroll
        for (int a = 0; a < 2; ++a)
#pragma unroll
            for (int b = 0; b < 2; ++b)
#pragma unroll
                for (int m = 0; m < 4; ++m)
#pragma unroll
                    for (int n = 0; n < 2; ++n) acc[a][b][m][n] = (f32x4){0.f, 0.f, 0.f, 0.f};
        cur = nxt; cA = nA; cB = nB; ++ui;
        if constexpr (ALIGN_EPI) { if (wr == 1) PG8_BAR; }
    }
    PG8_WAIT_V(0);
    if constexpr (!ALIGN_EPI) { if (wr == 0) PG8_BAR; }
    PG8_BAR;
    if constexpr (Epi::AFTER_DRAIN) { E.fused(acc, cur, wr, wc, fr, fq, lds, wid, lane); S.done(cur); }
#undef PG8_SA
#undef PG8_SB
#undef PG8_STAGE
#undef PG8_LDA
#undef PG8_LDB
#undef PG8_MMA
#undef PG8_WAIT_V
#undef PG8_WAIT_L
#undef PG8_BAR
#undef PG8_SCHED
}
}

using pg8::bf16_t; using pg8::bf16x8; using pg8::f32x4; using pg8::u32x4; using pg8::Unit; using pg8::Gemm; using pg8::StaticOrder; using pg8::cvt_pk_bf16;
#define LAS __attribute__((address_space(3)))
typedef LAS unsigned char* lds_t;
typedef float f32x16 __attribute__((ext_vector_type(16)));
typedef unsigned u32x2 __attribute__((ext_vector_type(2)));

constexpr int S = 8192, DM = 1024, NBATCH = 4, DEPTH = 4, NIN = 7960, NINP = 8192, DFF = 2816, NUP = 5632, SP = S + 64;
constexpr int NB = 2, MT = NB * S, NPASS = NBATCH / NB;
constexpr float EPS = 1e-6f, LOG2E = 1.4426950408889634f, LN2 = 0.6931471805599453f, QSCALE = 0.125f * LOG2E;
constexpr int NTHREADS = 512, LDS_BYTES = 131072 + 16;

constexpr size_t al256(size_t x) { return (x + 255) & ~(size_t)255; }
constexpr size_t O_BAR = 0;
constexpr size_t O_RS1 = 16384;
constexpr size_t O_RS2 = O_RS1 + (size_t)MT * 64;
constexpr size_t O_ROPE = O_RS2 + (size_t)MT * 64;
constexpr size_t O_POSB = O_ROPE + (size_t)S * 32 * 8;
constexpr size_t O_WIN = al256(O_POSB + 8 * 256 * 4);
constexpr size_t SZ_WIN = (size_t)NINP * DM * 2, SZ_WUP = (size_t)NUP * DM * 2, SZ_WDN = (size_t)DM * DFF * 2, SZ_WOUT = (size_t)DM * DM * 2, SZ_WP = (size_t)DM * 512 * 2, SZ_WC1 = (size_t)256 * 2048 * 2;
constexpr size_t O_WUP = O_WIN + 4 * SZ_WIN;
constexpr size_t O_WDN = O_WUP + 4 * SZ_WUP;
constexpr size_t O_WOUT = O_WDN + 4 * SZ_WDN;
constexpr size_t O_WPA = O_WOUT + 4 * SZ_WOUT;
constexpr size_t O_WPB = O_WPA + 4 * SZ_WP;
constexpr size_t O_WC1 = O_WPB + 4 * SZ_WP;
constexpr size_t O_XB = O_WC1 + 8 * SZ_WC1;
constexpr size_t O_QA = O_XB + (size_t)MT * DM * 2;
constexpr size_t SZ_A = (size_t)NB * 24 * S * 64 * 2, SZ_BKV = (size_t)NB * 2 * SP * 64 * 2;
constexpr size_t O_KA = O_QA + SZ_A;
constexpr size_t O_VA = O_KA + SZ_A;
constexpr size_t O_QB = O_VA + SZ_A;
constexpr size_t O_KCR = O_QB + (size_t)NB * 2 * S * 4 * 64 * 2;
constexpr size_t O_VCR = O_KCR + SZ_BKV;
constexpr size_t O_KS = O_VCR + SZ_BKV;
constexpr size_t O_VS = O_KS + SZ_BKV;
constexpr size_t O_KW = O_VS + SZ_BKV;
constexpr size_t O_VW = O_KW + SZ_BKV;
constexpr size_t O_GATE = O_VW + SZ_BKV;
constexpr size_t O_MG = O_GATE + (size_t)MT * 24 * 4;
constexpr size_t O_HID = O_MG + (size_t)MT * 2048 * 2;
constexpr size_t O_KC = O_HID + (size_t)NB * 4 * 512 * 256 * 2;
constexpr size_t O_VC = O_KC + (size_t)NB * 2 * 512 * 64 * 2;
constexpr size_t O_LSE = O_VC + (size_t)NB * 2 * 512 * 64 * 2;
constexpr size_t O_ENDMIX = O_LSE + (size_t)NB * 24 * S * 4;
constexpr size_t O_MIXED = O_KA;
constexpr size_t O_OUTA = O_VA;
constexpr size_t O_OUTB = O_VA + (size_t)MT * 512 * 2;
static_assert((size_t)MT * DM * 2 <= SZ_A && (size_t)2 * MT * 512 * 2 <= SZ_A, "overlay sizes");
constexpr size_t O_GU = O_QA;
constexpr size_t O_ACT = O_GU + (size_t)MT * NUP * 2;
constexpr size_t O_ENDFFN = O_ACT + (size_t)MT * DFF * 2;
constexpr size_t SZ_HALO = (size_t)(MT / 64) * 2 * DFF * 4;
constexpr size_t O_GH = al256(O_ENDMIX > O_ENDFFN ? O_ENDMIX : O_ENDFFN);
constexpr size_t O_G0 = O_GH + SZ_HALO;
constexpr size_t O_U0 = O_G0 + SZ_HALO;
constexpr size_t WS_NEED = O_U0 + SZ_HALO + 4096;

struct Params {
    const float* x; const float* norm_mix_g; const float* w_in; const float* a_q_g; const float* a_k_g; const float* b_q_g; const float* b_k_g;
    const float* cmp_pos; const float* cmp_w1; const float* cmp_w2; const float* w_proj_a; const float* w_proj_b; const float* w_out; const float* norm_ffn_g;
    const float* w_up; const float* conv_w; const float* conv_b; const float* w_down;
    float* out; unsigned char* ws; int ph_lo, ph_hi;
};

__device__ __forceinline__ float bf2f(unsigned short h) { return __uint_as_float((unsigned)h << 16); }
__device__ __forceinline__ float bflo(unsigned w) { return __uint_as_float(w << 16); }
__device__ __forceinline__ float bfhi(unsigned w) { return __uint_as_float(w & 0xffff0000u); }
__device__ __forceinline__ float wave_max(float v) {
#pragma unroll
    for (int o = 1; o < 64; o <<= 1) v = fmaxf(v, __shfl_xor(v, o));
    return v;
}
__device__ __forceinline__ float wave_sum(float v) {
#pragma unroll
    for (int o = 1; o < 64; o <<= 1) v += __shfl_xor(v, o);
    return v;
}
__device__ __forceinline__ float ld_sc1(const float* p) { return __hip_atomic_load(p, __ATOMIC_RELAXED, __HIP_MEMORY_SCOPE_AGENT); }
__device__ __forceinline__ float rs_sum(const float* rs, int row) {
    const f32x4* q = (const f32x4*)(rs + (size_t)row * 16); const f32x4 a = q[0], b = q[1], c = q[2], d = q[3];
    return (((a[0] + a[1]) + (a[2] + a[3])) + ((b[0] + b[1]) + (b[2] + b[3]))) + (((c[0] + c[1]) + (c[2] + c[3])) + ((d[0] + d[1]) + (d[2] + d[3])));
}
__device__ __forceinline__ float rs_sum4(const float* rs, int row, int fq) {
    const f32x4 a = *(const f32x4*)(rs + (size_t)row * 16 + 4 * fq); float s = (a[0] + a[1]) + (a[2] + a[3]);
    s += __shfl_xor(s, 16); s += __shfl_xor(s, 32); return s;
}
__device__ __forceinline__ float sigmoidf_(float v) { return __builtin_amdgcn_rcpf(1.f + __expf(-v)); }

struct EpiIn {
    static constexpr bool PERM = false, AFTER_DRAIN = false, HAS_MID = false;
    const float* rs; const float2* rope; const float* gqa; const float* gka; const float* gqb; const float* gkb;
    unsigned char* ws;
    __device__ __forceinline__ void operator()(const f32x4 (&acc)[2][2][4][2], const Unit& u, int wr, int wc, int fr, int fq) const {
        const int hd = 4 * u.pn + wc;
        if (hd >= 93 && hd < 96) return;
        const int bb = (u.pm * 256) >> 13;
        int mode; const float* gain = nullptr; float osc = 1.f; bf16_t* base = nullptr; int shift = 0; int g4 = 0;
        bool norm = false; int rowmul = 1;
        if (hd < 72) { const int kind = hd / 24, h = hd - kind * 24, gi = h >> 3; shift = 2 * gi; mode = 0;
            base = (bf16_t*)(ws + (kind == 0 ? O_QA : (kind == 1 ? O_KA : O_VA))) + (size_t)(bb * 24 + h) * S * 64;
            if (kind == 0) { norm = true; gain = gqa; osc = QSCALE; } else if (kind == 1) { norm = true; gain = gka; } }
        else if (hd < 80) { const int hq = hd - 72; mode = 0; norm = true; gain = gqb; osc = QSCALE; rowmul = 4; g4 = hq & 3; base = (bf16_t*)(ws + O_QB) + (size_t)(bb * 2 + (hq >> 2)) * S * 4 * 64; }
        else if (hd < 92) { const int idx = hd - 80, br = idx >> 2, kv = (idx >> 1) & 1, kvh = idx & 1; mode = 0;
            const size_t o = br == 0 ? (kv ? O_VCR : O_KCR) : (br == 1 ? (kv ? O_VS : O_KS) : (kv ? O_VW : O_KW));
            base = (bf16_t*)(ws + o) + (size_t)(bb * 2 + kvh) * SP * 64;
            if (kv == 0 && br > 0) { norm = true; gain = gkb + br * 64; } }
        else if (hd == 92) mode = 1; else mode = 2;
        float gn[2][2][4];
        if (norm) {
#pragma unroll
            for (int bj = 0; bj < 2; ++bj)
#pragma unroll
                for (int n = 0; n < 2; ++n) { const f32x4 gv = *(const f32x4*)(gain + 32 * bj + 16 * n + 4 * fq); gn[bj][n][0] = gv[0] * osc; gn[bj][n][1] = gv[1] * osc; gn[bj][n][2] = gv[2] * osc; gn[bj][n][3] = gv[3] * osc; }
        }
#pragma unroll
        for (int ai = 0; ai < 2; ++ai)
#pragma unroll
            for (int m = 0; m < 4; ++m) {
                const int tg = u.pm * 256 + ai * 128 + wr * 64 + m * 16 + fr, t = tg & (S - 1);
                const float rsc = rsqrtf(rs_sum4(rs, tg, fq) * (1.f / DM) + EPS);
                f32x4 v[2][2];
#pragma unroll
                for (int bj = 0; bj < 2; ++bj)
#pragma unroll
                    for (int n = 0; n < 2; ++n) v[bj][n] = acc[ai][bj][m][n] * rsc;
                if (mode == 0) {
                    if (norm) {
                        float ss = 0.f;
#pragma unroll
                        for (int bj = 0; bj < 2; ++bj)
#pragma unroll
                            for (int n = 0; n < 2; ++n) ss += (v[bj][n][0] * v[bj][n][0] + v[bj][n][1] * v[bj][n][1]) + (v[bj][n][2] * v[bj][n][2] + v[bj][n][3] * v[bj][n][3]);
                        ss += __shfl_xor(ss, 16); ss += __shfl_xor(ss, 32);
                        const float r = rsqrtf(ss * (1.f / 64.f) + EPS);
#pragma unroll
                        for (int n = 0; n < 2; ++n) {
                            const f32x4* rp = (const f32x4*)(rope + (size_t)t * 32 + 16 * n + 4 * fq); const f32x4 c01 = rp[0], c23 = rp[1];
#pragma unroll
                            for (int e = 0; e < 4; ++e) { float2 cs; cs.x = e < 2 ? c01[2 * e] : c23[2 * e - 4]; cs.y = e < 2 ? c01[2 * e + 1] : c23[2 * e - 3];
                                const float x1 = v[0][n][e] * r * gn[0][n][e], x2 = v[1][n][e] * r * gn[1][n][e];
                                v[0][n][e] = x1 * cs.x - x2 * cs.y; v[1][n][e] = x2 * cs.x + x1 * cs.y; }
                        }
                    }
                    size_t row;
                    if (rowmul == 4) row = (size_t)t * 4 + g4;
                    else if (hd < 72) { const int L = S >> shift; row = (size_t)(t & ((1 << shift) - 1)) * L + (t >> shift); }
                    else row = t;
                    bf16_t* dp = base + row * 64 + 4 * fq;
#pragma unroll
                    for (int bj = 0; bj < 2; ++bj)
#pragma unroll
                        for (int n = 0; n < 2; ++n) { u32x2 w; w.x = cvt_pk_bf16(v[bj][n][0], v[bj][n][1]); w.y = cvt_pk_bf16(v[bj][n][2], v[bj][n][3]); *(u32x2*)(dp + 32 * bj + 16 * n) = w; }
                } else if (mode == 1) {
                    float* gp = (float*)(ws + O_GATE) + (size_t)tg * 24;
                    { f32x4 o; o[0] = sigmoidf_(v[0][0][0]); o[1] = sigmoidf_(v[0][0][1]); o[2] = sigmoidf_(v[0][0][2]); o[3] = sigmoidf_(v[0][0][3]); *(f32x4*)(gp + 4 * fq) = o; }
                    if (fq < 2) { f32x4 o; o[0] = sigmoidf_(v[0][1][0]); o[1] = sigmoidf_(v[0][1][1]); o[2] = sigmoidf_(v[0][1][2]); o[3] = sigmoidf_(v[0][1][3]); *(f32x4*)(gp + 16 + 4 * fq) = o; }
                } else {
                    bf16_t* dp = (bf16_t*)(ws + O_MG) + (size_t)tg * 2048 + (hd - 96) * 64 + 4 * fq;
#pragma unroll
                    for (int bj = 0; bj < 2; ++bj)
#pragma unroll
                        for (int n = 0; n < 2; ++n) { u32x2 w; w.x = cvt_pk_bf16(sigmoidf_(v[bj][n][0]), sigmoidf_(v[bj][n][1])); w.y = cvt_pk_bf16(sigmoidf_(v[bj][n][2]), sigmoidf_(v[bj][n][3])); *(u32x2*)(dp + 32 * bj + 16 * n) = w; }
                }
            }
    }
};

__device__ __forceinline__ float gelu_tanh(float x) {
    const float u = 0.7978845608028654f * (x + 0.044715f * x * x * x);
    const float e = __expf(2.f * u);
    const float th = 1.f - 2.f * __builtin_amdgcn_rcpf(e + 1.f);
    return 0.5f * x * (1.f + th);
}
struct EpiGelu {
    static constexpr bool PERM = false, AFTER_DRAIN = false, HAS_MID = false;
    bf16_t* O; const float* bias;
    __device__ __forceinline__ void operator()(const f32x4 (&acc)[2][2][4][2], const Unit& u, int wr, int wc, int fr, int fq) const {
        const int col0 = u.pn * 256 + wc * 32 + 4 * fq;
#pragma unroll
        for (int ai = 0; ai < 2; ++ai)
#pragma unroll
            for (int m = 0; m < 4; ++m) { const int row = u.pm * 256 + ai * 128 + wr * 64 + m * 16 + fr;
#pragma unroll
                for (int bj = 0; bj < 2; ++bj)
#pragma unroll
                    for (int n = 0; n < 2; ++n) { const int c = col0 + 128 * bj + 16 * n; const f32x4 bv = *(const f32x4*)(bias + c); const f32x4 a = acc[ai][bj][m][n] + bv;
                        u32x2 w; w.x = cvt_pk_bf16(gelu_tanh(a[0]), gelu_tanh(a[1])); w.y = cvt_pk_bf16(gelu_tanh(a[2]), gelu_tanh(a[3])); *(u32x2*)(O + (size_t)row * 256 + c) = w; } }
    }
};
template <int SECOND> struct EpiProj {
    static constexpr bool PERM = false, AFTER_DRAIN = false, HAS_MID = false;
    bf16_t* O; const bf16_t* mg;
    __device__ __forceinline__ void operator()(const f32x4 (&acc)[2][2][4][2], const Unit& u, int wr, int wc, int fr, int fq) const {
        const int col0 = u.pn * 256 + wc * 32 + 4 * fq;
#pragma unroll
        for (int ai = 0; ai < 2; ++ai)
#pragma unroll
            for (int m = 0; m < 4; ++m) { const int row = u.pm * 256 + ai * 128 + wr * 64 + m * 16 + fr;
#pragma unroll
                for (int bj = 0; bj < 2; ++bj)
#pragma unroll
                    for (int n = 0; n < 2; ++n) { const int c = col0 + 128 * bj + 16 * n; const u32x2 g = *(const u32x2*)(mg + (size_t)row * 2048 + c); const f32x4 a = acc[ai][bj][m][n];
                        float o0 = bflo(g.x) * a[0], o1 = bfhi(g.x) * a[1], o2 = bflo(g.y) * a[2], o3 = bfhi(g.y) * a[3];
#ifdef ABL_NO_A
                        if (!SECOND) { o0 = o1 = o2 = o3 = 0.f; }
#endif
#ifdef ABL_NO_B
                        if (SECOND) { o0 = o1 = o2 = o3 = 0.f; }
#endif
                        bf16_t* op = O + (size_t)row * DM + c;
                        if (SECOND) { const u32x2 p = *(const u32x2*)op; o0 += bflo(p.x); o1 += bfhi(p.x); o2 += bflo(p.y); o3 += bfhi(p.y); }
                        u32x2 w; w.x = cvt_pk_bf16(o0, o1); w.y = cvt_pk_bf16(o2, o3); *(u32x2*)op = w; } }
    }
};
struct EpiProjF {
    static constexpr bool PERM = false, AFTER_DRAIN = false, HAS_MID = true;
    bf16_t* O; const bf16_t* mg;
    __device__ __forceinline__ void mid(f32x4 (&acc)[2][2][4][2], const Unit& u, int wr, int wc, int fr, int fq) const {
        const int col0 = u.pn * 256 + wc * 32 + 4 * fq;
#pragma unroll
        for (int ai = 0; ai < 2; ++ai)
#pragma unroll
            for (int m = 0; m < 4; ++m) { const int row = u.pm * 256 + ai * 128 + wr * 64 + m * 16 + fr;
#pragma unroll
                for (int bj = 0; bj < 2; ++bj)
#pragma unroll
                    for (int n = 0; n < 2; ++n) { const int c = col0 + 128 * bj + 16 * n; const u32x2 ga = *(const u32x2*)(mg + (size_t)row * 2048 + c), gb = *(const u32x2*)(mg + (size_t)row * 2048 + 1024 + c);
                        f32x4 a = acc[ai][bj][m][n];
                        a[0] *= bflo(ga.x) * __builtin_amdgcn_rcpf(bflo(gb.x)); a[1] *= bfhi(ga.x) * __builtin_amdgcn_rcpf(bfhi(gb.x)); a[2] *= bflo(ga.y) * __builtin_amdgcn_rcpf(bflo(gb.y)); a[3] *= bfhi(ga.y) * __builtin_amdgcn_rcpf(bfhi(gb.y));
                        acc[ai][bj][m][n] = a; } }
    }
    __device__ __forceinline__ void operator()(const f32x4 (&acc)[2][2][4][2], const Unit& u, int wr, int wc, int fr, int fq) const {
        const int col0 = u.pn * 256 + wc * 32 + 4 * fq;
#pragma unroll
        for (int ai = 0; ai < 2; ++ai)
#pragma unroll
            for (int m = 0; m < 4; ++m) { const int row = u.pm * 256 + ai * 128 + wr * 64 + m * 16 + fr;
#pragma unroll
                for (int bj = 0; bj < 2; ++bj)
#pragma unroll
                    for (int n = 0; n < 2; ++n) { const int c = col0 + 128 * bj + 16 * n; const u32x2 gb = *(const u32x2*)(mg + (size_t)row * 2048 + 1024 + c); const f32x4 a = acc[ai][bj][m][n];
                        u32x2 w; w.x = cvt_pk_bf16(a[0] * bflo(gb.x), a[1] * bfhi(gb.x)); w.y = cvt_pk_bf16(a[2] * bflo(gb.y), a[3] * bfhi(gb.y)); *(u32x2*)(O + (size_t)row * DM + c) = w; } }
    }
};
struct EpiRes {
    static constexpr bool PERM = false, AFTER_DRAIN = false, HAS_MID = false;
    float* xnew; bf16_t* xb; float* rso;
    __device__ __forceinline__ void operator()(const f32x4 (&acc)[2][2][4][2], const Unit& u, int wr, int wc, int fr, int fq) const {
        const int col0 = u.pn * 256 + wc * 32 + 4 * fq;
#pragma unroll
        for (int ai = 0; ai < 2; ++ai)
#pragma unroll
            for (int m = 0; m < 4; ++m) { const int row = u.pm * 256 + ai * 128 + wr * 64 + m * 16 + fr; float ss = 0.f;
#pragma unroll
                for (int bj = 0; bj < 2; ++bj)
#pragma unroll
                    for (int n = 0; n < 2; ++n) { const int c = col0 + 128 * bj + 16 * n; const size_t off = (size_t)row * DM + c; const u32x2 pv = *(const u32x2*)(xb + off); const f32x4 a = acc[ai][bj][m][n]; f32x4 o; o[0] = bflo(pv.x) + a[0]; o[1] = bfhi(pv.x) + a[1]; o[2] = bflo(pv.y) + a[2]; o[3] = bfhi(pv.y) + a[3];
                        if (xnew) *(f32x4*)(xnew + off) = o; u32x2 w; w.x = cvt_pk_bf16(o[0], o[1]); w.y = cvt_pk_bf16(o[2], o[3]); *(u32x2*)(xb + off) = w;
                        ss += (o[0] * o[0] + o[1] * o[1]) + (o[2] * o[2] + o[3] * o[3]); }
                ss += __shfl_xor(ss, 16); ss += __shfl_xor(ss, 32);
                if (fq == 0) rso[(size_t)row * 16 + u.pn * 4 + wc] = ss; }
    }
};
__device__ __forceinline__ float dpp_ror1(float v) { return __int_as_float(__builtin_amdgcn_update_dpp(0, __float_as_int(v), 0x121, 0xF, 0xF, true)); }
__device__ __forceinline__ float dpp_ror2(float v) { return __int_as_float(__builtin_amdgcn_update_dpp(0, __float_as_int(v), 0x122, 0xF, 0xF, true)); }
struct EpiUpConv {
    static constexpr bool PERM = false, AFTER_DRAIN = false, HAS_MID = false;
    bf16_t* act; const float* rs; const float* cw; const float* cb; float* gh; float* g0; float* u0;
    __device__ __forceinline__ void operator()(const f32x4 (&acc)[2][2][4][2], const Unit& u, int wr, int wc, int fr, int fq) const {
        const int colb = u.pn * 128 + wc * 32 + 4 * fq;
        float rscv[2][4];
#pragma unroll
        for (int ai = 0; ai < 2; ++ai)
#pragma unroll
            for (int m = 0; m < 4; ++m) rscv[ai][m] = rsqrtf(rs_sum4(rs, u.pm * 256 + ai * 128 + wr * 64 + m * 16 + fr, fq) * (1.f / DM) + EPS);
#pragma unroll
        for (int n = 0; n < 2; ++n) {
            const int c = colb + 16 * n;
            const f32x4 w0 = *(const f32x4*)(cw + c), w1 = *(const f32x4*)(cw + DFF + c), w2 = *(const f32x4*)(cw + 2 * DFF + c), bb = *(const f32x4*)(cb + c);
#pragma unroll
            for (int ai = 0; ai < 2; ++ai) {
                const int grp = u.pm * 4 + ai * 2 + wr;
                f32x4 pr1 = {0.f, 0.f, 0.f, 0.f}, pr2 = {0.f, 0.f, 0.f, 0.f};
#pragma unroll
                for (int m = 0; m < 4; ++m) {
                    const int row = u.pm * 256 + ai * 128 + wr * 64 + m * 16 + fr;
                    const float rsc = rscv[ai][m];
                    const f32x4 g = acc[ai][0][m][n] * rsc, uu = acc[ai][1][m][n] * rsc;
                    f32x4 r1, r2;
#pragma unroll
                    for (int e = 0; e < 4; ++e) { r1[e] = dpp_ror1(g[e]); r2[e] = dpp_ror2(g[e]); }
                    if (m == 0 && fr < 2) {
                        *(f32x4*)(g0 + ((size_t)grp * 2 + fr) * DFF + c) = g; *(f32x4*)(u0 + ((size_t)grp * 2 + fr) * DFF + c) = uu;
                    } else {
                        f32x4 o;
#pragma unroll
                        for (int e = 0; e < 4; ++e) { const float p1 = fr >= 1 ? r1[e] : pr1[e], p2 = fr >= 2 ? r2[e] : pr2[e];
                            const float z = bb[e] + w0[e] * p2 + w1[e] * p1 + w2[e] * g[e]; o[e] = z * sigmoidf_(z) * uu[e]; }
                        u32x2 w; w.x = cvt_pk_bf16(o[0], o[1]); w.y = cvt_pk_bf16(o[2], o[3]); *(u32x2*)(act + (size_t)row * DFF + c) = w;
                    }
                    if (m == 3 && fr >= 14) *(f32x4*)(gh + ((size_t)grp * 2 + (fr - 14)) * DFF + c) = g;
                    pr1 = r1; pr2 = r2;
                }
            }
        }
    }
};
struct EpiUp {
    static constexpr bool PERM = false, AFTER_DRAIN = false, HAS_MID = false;
    bf16_t* O; const float* rs;
    __device__ __forceinline__ void operator()(const f32x4 (&acc)[2][2][4][2], const Unit& u, int wr, int wc, int fr, int fq) const {
        const int col0 = u.pn * 256 + wc * 32 + 4 * fq;
#pragma unroll
        for (int ai = 0; ai < 2; ++ai)
#pragma unroll
            for (int m = 0; m < 4; ++m) { const int row = u.pm * 256 + ai * 128 + wr * 64 + m * 16 + fr; const float rsc = rsqrtf(rs_sum4(rs, row, fq) * (1.f / DM) + EPS);
#pragma unroll
                for (int bj = 0; bj < 2; ++bj)
#pragma unroll
                    for (int n = 0; n < 2; ++n) { const int c = col0 + 128 * bj + 16 * n; const f32x4 a = acc[ai][bj][m][n] * rsc;
                        u32x2 w; w.x = cvt_pk_bf16(a[0], a[1]); w.y = cvt_pk_bf16(a[2], a[3]); *(u32x2*)(O + (size_t)row * NUP + c) = w; } }
    }
};

__device__ __forceinline__ void transpose_item(const float* W, int ldn, int srccol0, int nvalid, const float* gain, bf16_t* dst, int K, int k0, LAS float* scr, int lane) {
    const int i = lane & 31;
#pragma unroll 8
    for (int j = 0; j < 32; ++j) { const int kk = 2 * j + (lane >> 5); float v = 0.f; if (i < nvalid) { v = W[(size_t)(k0 + kk) * ldn + srccol0 + i]; if (gain) v *= gain[k0 + kk]; } scr[kk * 33 + i] = v; }
    asm volatile("s_waitcnt lgkmcnt(0)" ::: "memory");
    const int c = lane & 7;
#pragma unroll
    for (int j = 0; j < 4; ++j) { const int n = (lane >> 3) + 8 * j; const LAS float* s = scr + (8 * c) * 33 + n;
        u32x4 o; o.x = cvt_pk_bf16(s[0 * 33], s[1 * 33]); o.y = cvt_pk_bf16(s[2 * 33], s[3 * 33]); o.z = cvt_pk_bf16(s[4 * 33], s[5 * 33]); o.w = cvt_pk_bf16(s[6 * 33], s[7 * 33]);
        *(u32x4*)(dst + (size_t)n * K + k0 + 8 * c) = o; }
    asm volatile("s_waitcnt lgkmcnt(0)" ::: "memory");
}
__device__ __forceinline__ void win_map(int n0, int& col0, int& nvalid) {
    const int pn = n0 >> 8, j = n0 & 255, bj = j >> 7, wc = (j & 127) >> 5, hd = 4 * pn + wc; nvalid = 32;
    if (hd < 92) col0 = 64 * hd + 32 * bj;
    else if (hd == 92) { col0 = 5888; nvalid = bj == 0 ? 24 : 0; }
    else if (hd < 96) { col0 = 0; nvalid = 0; }
    else col0 = 5912 + 64 * (hd - 96) + 32 * bj;
}
__device__ __forceinline__ void phase_prologue(const Params& p, lds_t lds) {
    const int tid = otid(), wave = tid >> 6, lane = tid & 63;
    LAS float* scr = (LAS float*)(lds + wave * 16384);
    const int gw = blockIdx.x * 8 + wave, NGW = gridDim.x * 8;
    constexpr int I_IN = 16 * 256, I_UP = 16 * 176, I_DN = 44 * 32, I_OUT = 16 * 32, I_P = 8 * 32, I_C1 = 32 * 8;
    constexpr int PER_L = I_IN + I_UP + I_DN + I_OUT + 2 * I_P + 2 * I_C1;
    for (int it = gw; it < 4 * PER_L; it += NGW) {
        const int l = it / PER_L; int r = it - l * PER_L;
        if (r < I_IN) { const int kb = r / 256, nb = r % 256; int c0, nv; win_map(nb * 32, c0, nv);
            transpose_item(p.w_in + (size_t)l * DM * NIN, NIN, c0, nv, p.norm_mix_g + l * DM, (bf16_t*)(p.ws + O_WIN + l * SZ_WIN) + (size_t)nb * 32 * DM, DM, kb * 64, scr, lane); continue; } r -= I_IN;
        if (r < I_UP) { const int kb = r / 176, nb = r % 176;
            transpose_item(p.w_up + (size_t)l * DM * NUP, NUP, (((nb * 32) >> 7) & 1) * DFF + ((nb * 32) >> 8) * 128 + ((nb * 32) & 127), 32, p.norm_ffn_g + l * DM, (bf16_t*)(p.ws + O_WUP + l * SZ_WUP) + (size_t)nb * 32 * DM, DM, kb * 64, scr, lane); continue; } r -= I_UP;
        if (r < I_DN) { const int kb = r / 32, nb = r % 32;
            transpose_item(p.w_down + (size_t)l * DFF * DM, DM, nb * 32, 32, nullptr, (bf16_t*)(p.ws + O_WDN + l * SZ_WDN) + (size_t)nb * 32 * DFF, DFF, kb * 64, scr, lane); continue; } r -= I_DN;
        if (r < I_OUT) { const int kb = r / 32, nb = r % 32;
            transpose_item(p.w_out + (size_t)l * DM * DM, DM, nb * 32, 32, nullptr, (bf16_t*)(p.ws + O_WOUT + l * SZ_WOUT) + (size_t)nb * 32 * DM, DM, kb * 64, scr, lane); continue; } r -= I_OUT;
        if (r < 2 * I_P) { const int which = r / I_P; r -= which * I_P; const int kb = r / 32, nb = r % 32;
            transpose_item((which ? p.w_proj_b : p.w_proj_a) + (size_t)l * 512 * DM, DM, nb * 32, 32, nullptr, (bf16_t*)(p.ws + O_WPA + l * 2 * SZ_WP) + (size_t)nb * 32 * 1024 + which * 512, 1024, kb * 64, scr, lane); continue; } r -= 2 * I_P;
        { const int kv = r / I_C1; r -= kv * I_C1; const int kb = r / 8, nb = r % 8;
            transpose_item(p.cmp_w1 + (size_t)(l * 2 + kv) * 2048 * 256, 256, nb * 32, 32, nullptr, (bf16_t*)(p.ws + O_WC1 + (size_t)(l * 2 + kv) * SZ_WC1) + (size_t)nb * 32 * 2048, 2048, kb * 64, scr, lane); }
    }
    float2* rope = (float2*)(p.ws + O_ROPE);
    for (int i = blockIdx.x * NTHREADS + tid; i < S * 32; i += gridDim.x * NTHREADS) {
        const int t = i >> 5, d = i & 31;
        const float invf = exp2f(-(float)d * (1.f / 32.f) * 13.287712379549449f);
        const float ang = (float)t * invf;
        const double rev = (double)ang * 0.15915494309189535;
        const double fr = rev - floor(rev + 0.5);
        const float xr = (float)(fr * 6.283185307179586);
        rope[i] = make_float2(cosf(xr), sinf(xr));
    }
    float* posb = (float*)(p.ws + O_POSB);
    LAS float* red = (LAS float*)lds;
    for (int item = blockIdx.x; item < 64; item += gridDim.x) {
        const int lk = item >> 3, n0 = (item & 7) * 32, nn = tid & 31, kp = tid >> 5;
        const float* pe = p.cmp_pos + (size_t)lk * 2048 + kp * 128; const float* w = p.cmp_w1 + (size_t)lk * 2048 * 256 + (size_t)(kp * 128) * 256 + n0 + nn;
        float sacc = 0.f;
#pragma unroll 8
        for (int k = 0; k < 128; ++k) sacc += pe[k] * w[(size_t)k * 256];
        __syncthreads();
        red[kp * 32 + nn] = sacc;
        __syncthreads();
        if (tid < 32) { float t = 0.f;
#pragma unroll
            for (int j = 0; j < 16; ++j) t += red[j * 32 + tid];
            posb[lk * 256 + n0 + tid] = t; }
    }
}
__device__ __forceinline__ void phase_x0(const Params& p, int b) {
    const int tid = otid(), wave = tid >> 6, lane = tid & 63;
    const float* x = p.x + (size_t)b * MT * DM; bf16_t* xb = (bf16_t*)(p.ws + O_XB); float* rs1 = (float*)(p.ws + O_RS1);
    for (int row = blockIdx.x * 8 + wave; row < MT; row += gridDim.x * 8) {
        const f32x4* xr = (const f32x4*)(x + (size_t)row * DM) + lane; u32x2* o = (u32x2*)(xb + (size_t)row * DM) + lane; float s = 0.f;
#pragma unroll
        for (int j = 0; j < 4; ++j) { const f32x4 v = xr[64 * j]; s += (v[0] * v[0] + v[1] * v[1]) + (v[2] * v[2] + v[3] * v[3]); u32x2 w; w.x = cvt_pk_bf16(v[0], v[1]); w.y = cvt_pk_bf16(v[2], v[3]); o[64 * j] = w; }
        s = wave_sum(s);
        if (lane < 16) rs1[(size_t)row * 16 + lane] = lane == 0 ? s : 0.f;
    }
}
__device__ __forceinline__ void zero_f32(float* ptr, int n) {
    for (int i = blockIdx.x * NTHREADS + otid(); i < n; i += gridDim.x * NTHREADS) ptr[i] = 0.f;
}

constexpr int KSTR = 144, ABUF = 2 * 64 * KSTR;
constexpr int LDS_SLC = 2 * ABUF;
constexpr int LDS_MASK = LDS_SLC + 64 * 129 * 4;
__device__ __forceinline__ float dpp_xor1(float v) { return __int_as_float(__builtin_amdgcn_update_dpp(0, __float_as_int(v), 0xB1, 0xF, 0xF, true)); }
__device__ __forceinline__ float dpp_xor2(float v) { return __int_as_float(__builtin_amdgcn_update_dpp(0, __float_as_int(v), 0x4E, 0xF, 0xF, true)); }

__device__ __forceinline__ u32x4 ld16_sc1(const void* ptr) {
#ifdef ABL_SC1
    u32x4 v; asm volatile("global_load_dwordx4 %0, %1, off sc0 sc1\n\ts_waitcnt vmcnt(0)" : "=v"(v) : "v"(ptr) : "memory"); return v;
#else
    return *(const u32x4*)ptr;
#endif
}
typedef float f32x2_t __attribute__((ext_vector_type(2))); typedef __bf16 bf16x2_t __attribute__((ext_vector_type(2)));
__device__ __forceinline__ unsigned cvtpk_s(float lo, float hi) { f32x2_t v = {lo, hi}; bf16x2_t b = __builtin_convertvector(v, bf16x2_t); return __builtin_bit_cast(unsigned, b); }
__device__ __forceinline__ float xhalf_sum(float v) {
    auto rr = __builtin_amdgcn_permlane32_swap(__float_as_uint(v), __float_as_uint(v), false, false);
    return __uint_as_float(rr[0]) + __uint_as_float(rr[1]);
}
struct AP { int qpos; int wlo, whi; unsigned m0, m1, m2, m3; int cur; float inv; int tokl; };

template <int MODE>
__device__ __forceinline__ void attn_tiles(lds_t lds, const bf16_t* Kg, const bf16_t* Vg, int tile_lo, int tile_hi, const bf16x8 (&qf)[4], float negM,
                                           f32x16& o0, f32x16& o1, float& l, const AP& ap) {
    if (tile_lo > tile_hi) return;
    const int tid = otid(), lane = tid & 63, r32 = lane & 31, hi = lane >> 5;
    const int lrow = tid >> 3, lch = tid & 7;
    const int vrow = tid & 63, vch = tid >> 6;
    const int vcol = (vrow & ~15) | (vrow & 3) | ((vrow & 4) << 1) | ((vrow & 8) >> 1);
    u32x4 kreg, vreg;
    { kreg = *(const u32x4*)(Kg + ((size_t)(tile_lo * 64 + lrow) * 64 + lch * 8)); if (MODE != 1) vreg = *(const u32x4*)(Vg + ((size_t)(tile_lo * 64 + vrow) * 64 + vch * 8)); }
    int bi = 0;
    for (int i = tile_lo; i <= tile_hi; ++i, bi ^= 1) {
        lds_t kb = lds + bi * ABUF, vb = kb + 64 * KSTR;
        *(LAS u32x4*)(kb + lrow * KSTR + lch * 16) = kreg;
        if (MODE != 1) {
            LAS unsigned short* vp = (LAS unsigned short*)(vb + (8 * vch) * KSTR + vcol * 2);
            vp[0 * (KSTR / 2)] = (unsigned short)(vreg.x & 0xffff); vp[1 * (KSTR / 2)] = (unsigned short)(vreg.x >> 16);
            vp[2 * (KSTR / 2)] = (unsigned short)(vreg.y & 0xffff); vp[3 * (KSTR / 2)] = (unsigned short)(vreg.y >> 16);
            vp[4 * (KSTR / 2)] = (unsigned short)(vreg.z & 0xffff); vp[5 * (KSTR / 2)] = (unsigned short)(vreg.z >> 16);
            vp[6 * (KSTR / 2)] = (unsigned short)(vreg.w & 0xffff); vp[7 * (KSTR / 2)] = (unsigned short)(vreg.w >> 16);
        }
        __syncthreads();
        if (i < tile_hi) { kreg = *(const u32x4*)(Kg + ((size_t)((i + 1) * 64 + lrow) * 64 + lch * 8)); if (MODE != 1) vreg = *(const u32x4*)(Vg + ((size_t)((i + 1) * 64 + vrow) * 64 + vch * 8)); }
        bool need;
        const int kvt = i * 64;
        if (MODE == 0) need = (kvt + 63 >= ap.wlo - 128) && (kvt <= ap.whi);
        else if (MODE == 1 || MODE == 2) need = kvt <= ap.whi;
        else if (MODE == 3) { const unsigned w = (i < 32) ? ap.m0 : (i < 64 ? ap.m1 : (i < 96 ? ap.m2 : ap.m3)); need = __any((int)((w >> (i & 31)) & 1u)) != 0; }
        else need = true;
        if (__builtin_amdgcn_readfirstlane((int)need)) {
            f32x16 p0, p1;
            bool bit = true;
            if (MODE == 3) { const unsigned w = (i < 32) ? ap.m0 : (i < 64 ? ap.m1 : (i < 96 ? ap.m2 : ap.m3)); bit = (w >> (i & 31)) & 1u; }
            const bool full = (MODE == 3) ? (i < ap.cur) : false;
            const float cinit = (MODE == 3 && !bit) ? -3.0e38f : negM;
#pragma unroll
            for (int r = 0; r < 16; ++r) { p0[r] = cinit; p1[r] = cinit; }
            bf16x8 kf[8];
#pragma unroll
            for (int s = 0; s < 4; ++s) {
                kf[2 * s] = *(const LAS bf16x8*)(kb + r32 * KSTR + (16 * s + 8 * hi) * 2);
                kf[2 * s + 1] = *(const LAS bf16x8*)(kb + (r32 + 32) * KSTR + (16 * s + 8 * hi) * 2);
            }
            __builtin_amdgcn_sched_barrier(0);
#pragma unroll
            for (int s = 0; s < 4; ++s) {
                p0 = __builtin_amdgcn_mfma_f32_32x32x16_bf16(kf[2 * s], qf[s], p0, 0, 0, 0);
                p1 = __builtin_amdgcn_mfma_f32_32x32x16_bf16(kf[2 * s + 1], qf[s], p1, 0, 0, 0);
            }
            __builtin_amdgcn_sched_barrier(0);
            bf16x8 vf[8];
            if (MODE != 1) {
#pragma unroll
                for (int kk = 0; kk < 2; ++kk)
#pragma unroll
                    for (int dt = 0; dt < 2; ++dt) vf[kk * 2 + dt] = *(const LAS bf16x8*)(vb + (32 * dt + r32) * KSTR + (16 * kk + 8 * hi) * 2);
            }
            __builtin_amdgcn_sched_barrier(0);
            const int kv0 = kvt + 4 * hi;
            float ls = 0.f;
            if (full) {
#pragma unroll
                for (int r = 0; r < 16; ++r) { const float e0 = __builtin_amdgcn_exp2f(p0[r]), e1 = __builtin_amdgcn_exp2f(p1[r]); p0[r] = e0; p1[r] = e1; ls += e0 + e1; }
            } else
#pragma unroll
            for (int r = 0; r < 16; ++r) {
                const int cr = (r & 3) + 8 * (r >> 2);
                const int k0 = kv0 + cr, k1 = k0 + 32;
                bool v0, v1;
                if (MODE == 0) { v0 = (unsigned)(ap.qpos - k0) <= 128u; v1 = (unsigned)(ap.qpos - k1) <= 128u; }
                else if (MODE == 1 || MODE == 2) { v0 = k0 <= ap.qpos; v1 = k1 <= ap.qpos; }
                else if (MODE == 3) { v0 = bit && (k0 <= ap.qpos); v1 = bit && (k1 <= ap.qpos); }
                else { v0 = (unsigned)(ap.qpos - k0) <= 511u; v1 = (unsigned)(ap.qpos - k1) <= 511u; }
                float e0 = __builtin_amdgcn_exp2f(p0[r]), e1 = __builtin_amdgcn_exp2f(p1[r]);
                e0 = v0 ? e0 : 0.f; e1 = v1 ? e1 : 0.f;
                if (MODE == 2) { e0 *= ap.inv; e1 *= ap.inv; }
                p0[r] = e0; p1[r] = e1; ls += e0 + e1;
            }
            l += ls;
            if (MODE == 2) {
                LAS float* slc = (LAS float*)(lds + LDS_SLC) + ap.tokl * 129;
#pragma unroll
                for (int h = 0; h < 2; ++h)
#pragma unroll
                    for (int rb = 0; rb < 4; ++rb) {
                        float a[4];
#pragma unroll
                        for (int e = 0; e < 4; ++e) { float v = h ? p1[4 * rb + e] : p0[4 * rb + e]; v += dpp_xor1(v); v += dpp_xor2(v); a[e] = v; }
                        const int blk = 16 * i + 2 * rb + hi + 8 * h;
                        if ((r32 & 3) == 0) { (void)__hip_atomic_fetch_add(slc + blk, 2.f * (a[0] + a[1] + a[2]) + a[3], __ATOMIC_RELAXED, __HIP_MEMORY_SCOPE_WORKGROUP); (void)__hip_atomic_fetch_add(slc + blk + 1, a[3], __ATOMIC_RELAXED, __HIP_MEMORY_SCOPE_WORKGROUP); }
                    }
            }
            if (MODE != 1) {
#pragma unroll
                for (int kk = 0; kk < 2; ++kk)
#pragma unroll
                    for (int dt = 0; dt < 2; ++dt) vf[4 + kk * 2 + dt] = *(const LAS bf16x8*)(vb + (32 * dt + r32) * KSTR + (32 + 16 * kk + 8 * hi) * 2);
                __builtin_amdgcn_sched_barrier(0);
#pragma unroll
                for (int h = 0; h < 2; ++h)
#pragma unroll
                    for (int kk = 0; kk < 2; ++kk) {
                        u32x4 pbu;
#pragma unroll
                        for (int j = 0; j < 4; ++j) pbu[j] = h ? cvtpk_s(p1[8 * kk + 2 * j], p1[8 * kk + 2 * j + 1]) : cvtpk_s(p0[8 * kk + 2 * j], p0[8 * kk + 2 * j + 1]);
                        const bf16x8 pbv = __builtin_bit_cast(bf16x8, pbu);
#pragma unroll
                        for (int dt = 0; dt < 2; ++dt) {
                            const bf16x8 avv = vf[(h * 2 + kk) * 2 + dt];
                            if (dt == 0) o0 = __builtin_amdgcn_mfma_f32_32x32x16_bf16(avv, pbv, o0, 0, 0, 0);
                            else o1 = __builtin_amdgcn_mfma_f32_32x32x16_bf16(avv, pbv, o1, 0, 0, 0);
                        }
                    }
            }
        }
#ifdef ABL_SYNC2
        __syncthreads();
#endif
    }
    __syncthreads();
}
__device__ __forceinline__ void load_q(bf16x8 (&qf)[4], const bf16_t* qrow, int hi) {
#pragma unroll
    for (int s = 0; s < 4; ++s) qf[s] = *(const bf16x8*)(qrow + 16 * s + 8 * hi);
}
__device__ __forceinline__ float gain_bound(const float* gq, const float* gk, int lane) {
#ifdef ABL_CONSTM
    return 12.5f;
#endif
    const float mq = wave_max(fabsf(gq[lane])), mk = wave_max(fabsf(gk[lane]));
    return 8.f * mq * mk * LOG2E * 1.02f + 0.05f;
}
__device__ __forceinline__ void zero16(f32x16& v) {
#pragma unroll
    for (int r = 0; r < 16; ++r) v[r] = 0.f;
}

__device__ __forceinline__ void dil_unit(const Params& p, lds_t lds, int l, int unit) {
    const int tid = otid(), wave = __builtin_amdgcn_readfirstlane(tid >> 6), lane = tid & 63, r32 = lane & 31, hi = lane >> 5;
    const int bb = unit / 768, u2 = unit - bb * 768, hd = u2 >> 5, pb = u2 & 31, gi = hd >> 3, shift = 2 * gi, L = S >> shift, bh = bb * 24 + hd;
    const bf16_t* Q = (const bf16_t*)(p.ws + O_QA) + (size_t)bh * S * 64; const bf16_t* K = (const bf16_t*)(p.ws + O_KA) + (size_t)bh * S * 64; const bf16_t* V = (const bf16_t*)(p.ws + O_VA) + (size_t)bh * S * 64;
#ifdef ABL_KQ
    K = Q; V = Q;
#endif
#ifdef ABL_KQ2
    V = K;
#endif
    const int pbase = pb * 256, cs = (pbase / L) * L;
    int lo = pbase - 128; if (lo < cs) lo = cs;
#ifdef ABL_NONEIGH
    lo = pbase;
#endif
    const float negM = -gain_bound(p.a_q_g + l * 64, p.a_k_g + l * 64, lane);
    AP ap; ap.qpos = pbase + 32 * wave + r32; ap.wlo = pbase + 32 * wave; ap.whi = ap.wlo + 31; ap.m0 = ap.m1 = ap.m2 = ap.m3 = 0; ap.cur = 0; ap.inv = 0.f; ap.tokl = 0;
    bf16x8 qf[4]; load_q(qf, Q + (size_t)ap.qpos * 64, hi);
    f32x16 o0, o1; zero16(o0); zero16(o1); float lsum = 0.f;
#ifdef ABL_DIL_Q
#pragma unroll
    for (int r = 0; r < 16; ++r) { o0[r] = bf2f((unsigned short)qf[r & 3][r >> 2]); o1[r] = bf2f((unsigned short)qf[r & 3][4 + (r >> 2)]); }
    lsum = 1.f + 0.01f * (float)r32;
#else
    attn_tiles<0>(lds, K, V, lo >> 6, (pbase + 255) >> 6, qf, negM, o0, o1, lsum, ap);
#endif
#ifdef ABL_DISCARD
    { float* scr = (float*)(p.ws + O_ENDMIX) + ((size_t)unit * 512 + tid) * 36;
#pragma unroll
    for (int r = 0; r < 16; ++r) { scr[r] = o0[r]; scr[16 + r] = o1[r]; o0[r] = bf2f((unsigned short)qf[r & 3][r >> 2]); o1[r] = bf2f((unsigned short)qf[r & 3][4 + (r >> 2)]); }
    scr[32] = lsum; lsum = 1.f + 0.01f * (float)r32; }
#endif
    lsum = xhalf_sum(lsum);
#ifdef ABL_INV1
    const float inv = 30.f;
#else
    const float inv = 1.f / lsum;
#endif
    const int qp = ap.qpos;
    bf16_t* op = (bf16_t*)(p.ws + O_QA) + ((size_t)bh * S + qp) * 64 + 4 * hi;
#pragma unroll
    for (int rb = 0; rb < 4; ++rb) {
        u32x2 w; w.x = cvt_pk_bf16(o0[4 * rb] * inv, o0[4 * rb + 1] * inv); w.y = cvt_pk_bf16(o0[4 * rb + 2] * inv, o0[4 * rb + 3] * inv); *(u32x2*)(op + 8 * rb) = w;
        w.x = cvt_pk_bf16(o1[4 * rb] * inv, o1[4 * rb + 1] * inv); w.y = cvt_pk_bf16(o1[4 * rb + 2] * inv, o1[4 * rb + 3] * inv); *(u32x2*)(op + 32 + 8 * rb) = w;
    }
    if (hi == 0) ((float*)(p.ws + O_LSE))[(size_t)bh * S + qp] = (__log2f(lsum) - negM) * LN2;
}

__device__ __forceinline__ void cmp2_task(const Params& p, int l, int task, int lane) {
    const int bb = task >> 11, idx = (task >> 9) & 3, c = task & 511, kv = idx >> 1, kvh = idx & 1;
    bf16_t* dst = (bf16_t*)(p.ws + (kv ? O_VC : O_KC)) + ((size_t)(bb * 2 + kvh) * 512 + c) * 64;
    if (c == 511) { dst[lane] = 0; return; }
    const bf16_t* hid = (const bf16_t*)(p.ws + O_HID) + ((size_t)(bb * 4 + idx) * 512 + c) * 256;
    const float* w2 = p.cmp_w2 + (size_t)(l * 2 + kv) * 256 * 64 + lane;
    float sa[8];
#pragma unroll
    for (int j = 0; j < 8; ++j) sa[j] = 0.f;
#pragma unroll 4
    for (int k = 0; k < 256; k += 8) { const u32x4 h = *(const u32x4*)(hid + k); const float* wk = w2 + (size_t)k * 64;
        sa[0] += bflo(h.x) * wk[0]; sa[1] += bfhi(h.x) * wk[64]; sa[2] += bflo(h.y) * wk[128]; sa[3] += bfhi(h.y) * wk[192];
        sa[4] += bflo(h.z) * wk[256]; sa[5] += bfhi(h.z) * wk[320]; sa[6] += bflo(h.w) * wk[384]; sa[7] += bfhi(h.w) * wk[448]; }
    float s = ((sa[0] + sa[1]) + (sa[2] + sa[3])) + ((sa[4] + sa[5]) + (sa[6] + sa[7]));
    if (kv == 0) {
        const float ss = wave_sum(s * s);
        const float y = s * rsqrtf(ss * (1.f / 64.f) + EPS) * p.b_k_g[(size_t)l * 192 + lane];
        const float other = __shfl_xor(y, 32);
        const float2 cs = ((const float2*)(p.ws + O_ROPE))[(size_t)(16 * c + 31) * 32 + (lane & 31)];
        s = lane < 32 ? (y * cs.x - other * cs.y) : (y * cs.x + other * cs.y);
    }
    const unsigned w = cvt_pk_bf16(s, 0.f);
    dst[lane] = (unsigned short)(w & 0xffff);
}

__device__ __forceinline__ void nsa_unit(const Params& p, lds_t lds, int l, int unit) {
    const int tid = otid(), wave = __builtin_amdgcn_readfirstlane(tid >> 6), lane = tid & 63, r32 = lane & 31, hi = lane >> 5;
    const int kvh = unit & 1, bb = (unit >> 1) & 1, tb = unit >> 2, t0 = tb * 64, cur = tb, bk = bb * 2 + kvh;
    {
        const int tok = tid >> 3, ch = tid & 7, t = t0 + tok, j = 4 * kvh + (ch >> 1), c0 = j * 64 + (ch & 1) * 32;
        const float* lse = (const float*)(p.ws + O_LSE);
        const size_t r0 = (size_t)(bb * 24 + j) * S + t, r1 = (size_t)(bb * 24 + 8 + j) * S + (size_t)(t & 3) * (S >> 2) + (t >> 2), r2 = (size_t)(bb * 24 + 16 + j) * S + (size_t)(t & 15) * (S >> 4) + (t >> 4);
        const float l0 = lse[r0], l1 = lse[r1], l2 = lse[r2];
        const float mx = fmaxf(l0, fmaxf(l1, l2)); float w0 = __expf(l0 - mx), w1 = __expf(l1 - mx), w2 = __expf(l2 - mx); const float is = 1.f / (w0 + w1 + w2); w0 *= is; w1 *= is; w2 *= is;
        const bf16_t* oa = (const bf16_t*)(p.ws + O_QA) + (ch & 1) * 32; bf16_t* out = (bf16_t*)(p.ws + O_OUTA) + ((size_t)bb * S + t) * 1024 + c0;
#pragma unroll
        for (int q = 0; q < 4; ++q) {
            const u32x4 a = *(const u32x4*)(oa + r0 * 64 + 8 * q), b = *(const u32x4*)(oa + r1 * 64 + 8 * q), c = *(const u32x4*)(oa + r2 * 64 + 8 * q);
            u32x4 o;
            o.x = cvt_pk_bf16(w0 * bflo(a.x) + w1 * bflo(b.x) + w2 * bflo(c.x), w0 * bfhi(a.x) + w1 * bfhi(b.x) + w2 * bfhi(c.x));
            o.y = cvt_pk_bf16(w0 * bflo(a.y) + w1 * bflo(b.y) + w2 * bflo(c.y), w0 * bfhi(a.y) + w1 * bfhi(b.y) + w2 * bfhi(c.y));
            o.z = cvt_pk_bf16(w0 * bflo(a.z) + w1 * bflo(b.z) + w2 * bflo(c.z), w0 * bfhi(a.z) + w1 * bfhi(b.z) + w2 * bfhi(c.z));
            o.w = cvt_pk_bf16(w0 * bflo(a.w) + w1 * bflo(b.w) + w2 * bflo(c.w), w0 * bfhi(a.w) + w1 * bfhi(b.w) + w2 * bfhi(c.w));
#ifdef ABL_CONST_OUTA
            { const float f0 = 0.01f * (float)((c0 + 8 * q) % 7) + 0.001f * (float)(t % 5); o.x = cvt_pk_bf16(f0, -f0); o.y = cvt_pk_bf16(f0 * 2.f, f0); o.z = o.x; o.w = o.y; }
#endif
            *(u32x4*)(out + 8 * q) = o;
        }
    }
    const int tokl = 8 * wave + (r32 >> 2), g = r32 & 3, t = t0 + tokl;
    const bf16_t* Q = (const bf16_t*)(p.ws + O_QB) + (((size_t)bk * S + t) * 4 + g) * 64;
    bf16x8 qf[4]; load_q(qf, Q, hi);
    const float* gate = (const float*)(p.ws + O_GATE) + ((size_t)bb * S + t) * 24 + kvh * 4 + g;
    float g_cmp = gate[0], g_sel = gate[8], g_win = gate[16];
#ifdef ABL_NO_CMP
    g_cmp = 0.f;
#endif
#ifdef ABL_NO_SEL
    g_sel = 0.f;
#endif
#ifdef ABL_NO_WIN
    g_win = 0.f;
#endif
    LAS float* slc = (LAS float*)(lds + LDS_SLC); LAS unsigned* maskw = (LAS unsigned*)(lds + LDS_MASK);
    for (int i = tid; i < 64 * 129; i += NTHREADS) slc[i] = 0.f;
    __syncthreads();
    f32x16 acc0, acc1; zero16(acc0); zero16(acc1);
    AP ap; ap.m0 = ap.m1 = ap.m2 = ap.m3 = 0; ap.cur = cur; ap.tokl = tokl; ap.inv = 0.f; ap.wlo = 0;
    {
        const bf16_t* K = (const bf16_t*)(p.ws + O_KC) + (size_t)bk * 512 * 64; const bf16_t* V = (const bf16_t*)(p.ws + O_VC) + (size_t)bk * 512 * 64;
        const float negM = -gain_bound(p.b_q_g + l * 64, p.b_k_g + (size_t)l * 192, lane);
        const int cmax_u = (t0 + 63 - 31) >> 4;
        ap.qpos = (t - 31) >> 4; ap.whi = (t0 + 8 * wave + 7 - 31) >> 4;
        if (cmax_u >= 0) {
            const int thi = cmax_u >> 6;
            f32x16 o0, o1; zero16(o0); zero16(o1); float l1 = 0.f, l2 = 0.f;
            attn_tiles<1>(lds, K, V, 0, thi, qf, negM, o0, o1, l1, ap);
            l1 = xhalf_sum(l1);
            ap.inv = l1 > 0.f ? 1.f / l1 : 0.f;
            attn_tiles<2>(lds, K, V, 0, thi, qf, negM, o0, o1, l2, ap);
#pragma unroll
            for (int r = 0; r < 16; ++r) { acc0[r] = g_cmp * o0[r]; acc1[r] = g_cmp * o1[r]; }
        }
    }
    __syncthreads();
    if (wave == 0) {
        unsigned m0 = 0, m1 = 0, m2 = 0, m3 = 0;
        if (cur < 16) { m0 = (2u << cur) - 1u; }
        else {
            float top[13];
#pragma unroll
            for (int i = 0; i < 13; ++i) top[i] = -2.f;
            const LAS float* sr = slc + lane * 129;
            for (int b = 1; b <= cur - 2; ++b) { float v = sr[b];
#pragma unroll
                for (int i = 0; i < 13; ++i) { const float hi_ = fmaxf(top[i], v); v = fminf(top[i], v); top[i] = hi_; } }
            const float thr = top[12]; int ngt = 0;
            for (int b = 1; b <= cur - 2; ++b) ngt += sr[b] > thr ? 1 : 0;
            int need_eq = 13 - ngt;
            for (int b = 1; b <= cur - 2; ++b) { const float v = sr[b]; bool sel = v > thr; if (!sel && v == thr && need_eq > 0) { sel = true; --need_eq; }
                const unsigned bitv = sel ? (1u << (b & 31)) : 0u;
                if (b < 32) m0 |= bitv; else if (b < 64) m1 |= bitv; else if (b < 96) m2 |= bitv; else m3 |= bitv; }
            m0 |= 1u;
            { const int b = cur; const unsigned bv = 1u << (b & 31); if (b < 32) m0 |= bv; else if (b < 64) m1 |= bv; else if (b < 96) m2 |= bv; else m3 |= bv; }
            { const int b = cur - 1; const unsigned bv = 1u << (b & 31); if (b < 32) m0 |= bv; else if (b < 64) m1 |= bv; else if (b < 96) m2 |= bv; else m3 |= bv; }
        }
        maskw[lane * 4 + 0] = m0; maskw[lane * 4 + 1] = m1; maskw[lane * 4 + 2] = m2; maskw[lane * 4 + 3] = m3;
    }
    __syncthreads();
    ap.m0 = maskw[tokl * 4 + 0]; ap.m1 = maskw[tokl * 4 + 1]; ap.m2 = maskw[tokl * 4 + 2]; ap.m3 = maskw[tokl * 4 + 3];
    ap.qpos = t;
    {
        const bf16_t* K = (const bf16_t*)(p.ws + O_KS) + (size_t)bk * SP * 64; const bf16_t* V = (const bf16_t*)(p.ws + O_VS) + (size_t)bk * SP * 64;
        const float negM = -gain_bound(p.b_q_g + l * 64, p.b_k_g + (size_t)l * 192 + 64, lane);
        f32x16 o0, o1; zero16(o0); zero16(o1); float ls = 0.f;
        attn_tiles<3>(lds, K, V, 0, cur, qf, negM, o0, o1, ls, ap);
        ls = xhalf_sum(ls);
        const float sc = g_sel / ls;
#pragma unroll
        for (int r = 0; r < 16; ++r) { acc0[r] += sc * o0[r]; acc1[r] += sc * o1[r]; }
    }
    {
        const bf16_t* K = (const bf16_t*)(p.ws + O_KW) + (size_t)bk * SP * 64; const bf16_t* V = (const bf16_t*)(p.ws + O_VW) + (size_t)bk * SP * 64;
        const float negM = -gain_bound(p.b_q_g + l * 64, p.b_k_g + (size_t)l * 192 + 128, lane);
        f32x16 o0, o1; zero16(o0); zero16(o1); float ls = 0.f;
        attn_tiles<4>(lds, K, V, cur >= 8 ? cur - 8 : 0, cur, qf, negM, o0, o1, ls, ap);
        ls = xhalf_sum(ls);
        const float sc = g_win / ls;
#pragma unroll
        for (int r = 0; r < 16; ++r) { acc0[r] += sc * o0[r]; acc1[r] += sc * o1[r]; }
    }
    bf16_t* op = (bf16_t*)(p.ws + O_OUTA) + ((size_t)bb * S + t) * 1024 + 512 + (kvh * 4 + g) * 64 + 4 * hi;
#pragma unroll
    for (int rb = 0; rb < 4; ++rb) {
        u32x2 w; w.x = cvt_pk_bf16(acc0[4 * rb], acc0[4 * rb + 1]); w.y = cvt_pk_bf16(acc0[4 * rb + 2], acc0[4 * rb + 3]); *(u32x2*)(op + 8 * rb) = w;
        w.x = cvt_pk_bf16(acc1[4 * rb], acc1[4 * rb + 1]); w.y = cvt_pk_bf16(acc1[4 * rb + 2], acc1[4 * rb + 3]); *(u32x2*)(op + 32 + 8 * rb) = w;
    }
    __syncthreads();
}

__device__ __forceinline__ void phase_conv(const Params& p, int l) {
    bf16_t* act = (bf16_t*)(p.ws + O_ACT); const float* gh = (const float*)(p.ws + O_GH); const float* g0 = (const float*)(p.ws + O_G0); const float* u0 = (const float*)(p.ws + O_U0);
    const float* cw = p.conv_w + (size_t)l * 3 * DFF; const float* cb = p.conv_b + (size_t)l * DFF;
    constexpr int NCH4 = DFF / 4, NGRP = MT / 64;
    for (int it = blockIdx.x * NTHREADS + otid(); it < NCH4 * NGRP; it += gridDim.x * NTHREADS) {
        const int ch = it % NCH4, grp = it / NCH4, c = ch * 4;
        const bool first = (grp & (S / 64 - 1)) == 0;
        const f32x4 z4 = {0.f, 0.f, 0.f, 0.f};
        const f32x4 w0 = *(const f32x4*)(cw + c), w1 = *(const f32x4*)(cw + DFF + c), w2 = *(const f32x4*)(cw + 2 * DFF + c), bb = *(const f32x4*)(cb + c);
        const f32x4 q2 = first ? z4 : *(const f32x4*)(gh + ((size_t)(grp - (first ? 0 : 1)) * 2 + 0) * DFF + c), q1 = first ? z4 : *(const f32x4*)(gh + ((size_t)(grp - (first ? 0 : 1)) * 2 + 1) * DFF + c);
        const f32x4 ga = *(const f32x4*)(g0 + ((size_t)grp * 2 + 0) * DFF + c), gb = *(const f32x4*)(g0 + ((size_t)grp * 2 + 1) * DFF + c);
        const f32x4 ua = *(const f32x4*)(u0 + ((size_t)grp * 2 + 0) * DFF + c), ub = *(const f32x4*)(u0 + ((size_t)grp * 2 + 1) * DFF + c);
        f32x4 oa, ob;
#pragma unroll
        for (int e = 0; e < 4; ++e) { const float za = bb[e] + w0[e] * q2[e] + w1[e] * q1[e] + w2[e] * ga[e]; oa[e] = za * sigmoidf_(za) * ua[e];
            const float zb = bb[e] + w0[e] * q1[e] + w1[e] * ga[e] + w2[e] * gb[e]; ob[e] = zb * sigmoidf_(zb) * ub[e]; }
        u32x2 w; w.x = cvt_pk_bf16(oa[0], oa[1]); w.y = cvt_pk_bf16(oa[2], oa[3]); *(u32x2*)(act + ((size_t)grp * 64 + 0) * DFF + c) = w;
        w.x = cvt_pk_bf16(ob[0], ob[1]); w.y = cvt_pk_bf16(ob[2], ob[3]); *(u32x2*)(act + ((size_t)grp * 64 + 1) * DFF + c) = w;
    }
}

#ifndef PHEN
#define PHEN 0xFFFF
#endif
#define EN(n) (((PHEN) >> (n)) & 1)
__device__ __forceinline__ void my_grid_bar(unsigned* bar) {
    asm volatile("s_waitcnt vmcnt(0) lgkmcnt(0)" ::: "memory");
    __syncthreads();
    if (threadIdx.x == 0) {
        const unsigned G = gridDim.x;
        __builtin_amdgcn_fence(__ATOMIC_RELEASE, "agent");
        asm volatile("s_waitcnt vmcnt(0)" ::: "memory");
        const unsigned g0 = __hip_atomic_load(bar + 64, __ATOMIC_RELAXED, __HIP_MEMORY_SCOPE_AGENT);
        const unsigned old = __hip_atomic_fetch_add(bar, 1u, __ATOMIC_RELAXED, __HIP_MEMORY_SCOPE_AGENT);
        const unsigned base = (old >= 0xAAAAAAAAu && old - 0xAAAAAAAAu < G) ? 0xAAAAAAAAu : 0u;
        if (old - base == G - 1u) { __hip_atomic_store(bar, 0u, __ATOMIC_RELAXED, __HIP_MEMORY_SCOPE_AGENT); (void)__hip_atomic_fetch_add(bar + 64, 1u, __ATOMIC_RELEASE, __HIP_MEMORY_SCOPE_AGENT); }
        else while (__hip_atomic_load(bar + 64, __ATOMIC_RELAXED, __HIP_MEMORY_SCOPE_AGENT) == g0) __builtin_amdgcn_s_sleep(2);
        __builtin_amdgcn_fence(__ATOMIC_ACQUIRE, "agent");
        asm volatile("s_waitcnt vmcnt(0)" ::: "memory");
    }
    __syncthreads();
}
#define XB_TMO      128
#define XB_XCNT(j)  (256  + 64 * (j))
#define XB_XSUB(j)  (1280 + 64 * (j))
#define XB_XGEN(j)  (2304 + 64 * (j))
#define XB_TOP      3328
#define XB_TOPGEN   3392
#define XCD_BAR_WORDS 3456
#define XB_SPIN_CAP (1u << 18)

__device__ __forceinline__ unsigned xb_ld(unsigned* p)              { return __hip_atomic_load(p, __ATOMIC_RELAXED, __HIP_MEMORY_SCOPE_AGENT); }
__device__ __forceinline__ unsigned xb_add(unsigned* p, unsigned v) { return __hip_atomic_fetch_add(p, v, __ATOMIC_RELAXED, __HIP_MEMORY_SCOPE_AGENT); }
__device__ __forceinline__ unsigned xb_xcc_id() { return (unsigned)__builtin_amdgcn_s_getreg((3 << 11) | 20) & 0xFu; }
#define XB_SPIN(cond, bar) do { unsigned _sp = 0; while (cond) { __builtin_amdgcn_s_sleep(1); \
    if ((++_sp & 255u) == 0u) { if (xb_ld(&(bar)[XB_TMO])) break; if (_sp > XB_SPIN_CAP) { atomicAdd(&(bar)[XB_TMO], 1u); break; } } } } while (0)

struct XcdBarrier {
    unsigned* bar; unsigned x;
    volatile LAS unsigned* st;
};

__device__ __forceinline__ XcdBarrier xcd_barrier_post(unsigned* bar, volatile LAS unsigned* st) {
    XcdBarrier b; b.bar = bar; b.x = xb_xcc_id(); b.st = st;
    if (threadIdx.x == 0) (void)xb_add(&bar[XB_XCNT(b.x)], 1u);
    return b;
}
__device__ __forceinline__ void xcd_barrier_complete(unsigned* bar, unsigned x, unsigned& nloc, unsigned& nx) {
    const unsigned G = gridDim.x * gridDim.y * gridDim.z;
    unsigned sum, cnt, mine, sp = 0u;
    for (;;) {
        sum = 0u; cnt = 0u; mine = 0u;
#pragma unroll
        for (unsigned j = 0; j < 16; ++j) { const unsigned c = xb_ld(&bar[XB_XCNT(j)]); sum += c; cnt += (c > 0u) ? 1u : 0u; mine = (j == x) ? c : mine; }
        if (sum == G) break;
        __builtin_amdgcn_s_sleep(1);
        if ((++sp & 255u) == 0u) { if (xb_ld(&bar[XB_TMO])) break; if (sp > XB_SPIN_CAP) { atomicAdd(&bar[XB_TMO], 1u); break; } }
    }
    nloc = mine > 0u ? mine : 1u; nx = cnt > 0u ? cnt : 1u;
}

__device__ __forceinline__ void xcd_barrier(const XcdBarrier& b) {
    asm volatile("s_waitcnt vmcnt(0)" ::: "memory");
    __syncthreads();
    if (threadIdx.x == 0) {
        unsigned* bar = b.bar;
        __builtin_amdgcn_s_waitcnt(0);
        unsigned nloc = b.st[0], nx = b.st[1];
        if (nloc == 0u) { xcd_barrier_complete(bar, b.x, nloc, nx); b.st[0] = nloc; b.st[1] = nx; }
        const unsigned old = xb_add(&bar[XB_XSUB(b.x)], 1u);
        const unsigned gen = old / nloc;
        if (old + 1u == (gen + 1u) * nloc) {
            __builtin_amdgcn_fence(__ATOMIC_RELEASE, "agent");
            asm volatile("s_waitcnt vmcnt(0)" ::: "memory");
            const unsigned og = xb_add(&bar[XB_TOP], 1u);
            const unsigned tg = og / nx;
            if (og + 1u == (tg + 1u) * nx) xb_add(&bar[XB_TOPGEN], 1u);
            else XB_SPIN(xb_ld(&bar[XB_TOPGEN]) == tg, bar);
            __builtin_amdgcn_fence(__ATOMIC_ACQUIRE, "agent");
            xb_add(&bar[XB_XGEN(b.x)], 1u);
            asm volatile("s_waitcnt vmcnt(0)" ::: "memory");
        } else {
            XB_SPIN(xb_ld(&bar[XB_XGEN(b.x)]) == gen, bar);
            __builtin_amdgcn_fence(__ATOMIC_ACQUIRE, "agent");
            asm volatile("s_waitcnt vmcnt(0)" ::: "memory");
        }
    }
    __syncthreads();
}
constexpr int STEPS = 9, PER_PASS = 1 + DEPTH * STEPS, NPHASES = 1 + NPASS * PER_PASS;

__global__ void __launch_bounds__(NTHREADS, 2) mega_fwd(Params p) {
    extern __shared__ __attribute__((aligned(16))) unsigned char lds_raw[];
    lds_t lds = (lds_t)lds_raw;
    cg::grid_group grid = cg::this_grid();
    const int G = gridDim.x;
    volatile LAS unsigned* xst = (volatile LAS unsigned*)(lds + 131072);
    if (threadIdx.x == 0) { xst[0] = 0u; xst[1] = 0u; }
    __syncthreads();
    const XcdBarrier xbar = xcd_barrier_post((unsigned*)(p.ws + O_BAR), xst);
#pragma nounroll
    for (int ph = p.ph_lo; ph < p.ph_hi; ++ph) {
        int c = blockIdx.x; asm volatile("" : "+s"(c));
        const int tid = otid(), wave = tid >> 6, lane = tid & 63;
        if (ph == 0) phase_prologue(p, lds);
        else {
            const int q = ph - 1, b = q / PER_PASS, r = q % PER_PASS;
            if (r == 0) phase_x0(p, b);
            else {
                const int l = (r - 1) / STEPS, st = (r - 1) % STEPS;
                unsigned char* ws = p.ws;
                float* xout = p.out + (size_t)b * MT * DM;
                if (st == 0) {
                    Gemm g{(const bf16_t*)(ws + O_XB), (const bf16_t*)(ws + O_WIN + l * SZ_WIN), MT, NINP, DM, DM};
                    StaticOrder so; so.init(MT, NINP, G, c);
                    EpiIn e{(const float*)(ws + O_RS1), (const float2*)(ws + O_ROPE), p.a_q_g + l * 64, p.a_k_g + l * 64, p.b_q_g + l * 64, p.b_k_g + (size_t)l * 192, ws};
                    pg8::gemm_phase<EpiIn, StaticOrder, true, true>(lds, g, so, e);
#ifdef PROBE_IN2
                    pg8::gemm_phase<EpiIn, StaticOrder, true, true>(lds, g, so, e);
#endif
                } else if (st == 1 || st == 2) {
                    if (st == 1) {
#pragma unroll 1
                        for (int idx = 0; idx < 4 * NB; ++idx) { const int bb = idx >> 2, kv = (idx >> 1) & 1, kvh = idx & 1;
                            Gemm g{(const bf16_t*)(ws + (kv ? O_VCR : O_KCR)) + (size_t)(bb * 2 + kvh) * SP * 64, (const bf16_t*)(ws + O_WC1 + (size_t)(l * 2 + kv) * SZ_WC1), 512, 256, 2048, 1024};
                            StaticOrder so; so.init(512, 256, G, (c + G - 2 * idx) % G);
                            EpiGelu e{(bf16_t*)(ws + O_HID) + (size_t)idx * 512 * 256, (const float*)(ws + O_POSB) + (l * 2 + kv) * 256};
                            pg8::gemm_phase<EpiGelu, StaticOrder, true, true>(lds, g, so, e);
                        }
                    } else {
                        for (int task = c * 8 + wave; task < NB * 2048; task += G * 8) cmp2_task(p, l, task, lane);
                    }
                    constexpr int HALF_U = NB * 768 / 2;
                    const int u0 = st == 1 ? 0 : HALF_U;
                    if (st == 1) {
                        unsigned* ctr = (unsigned*)(ws + O_BAR) + 3600 + (b * DEPTH + l);
                        volatile LAS unsigned* slot = (volatile LAS unsigned*)(lds + 131072 + 8);
                        for (;;) {
                            __syncthreads();
                            if (threadIdx.x == 0) slot[0] = __hip_atomic_fetch_add(ctr, 1u, __ATOMIC_RELAXED, __HIP_MEMORY_SCOPE_AGENT);
                            __syncthreads();
                            const int u = (int)slot[0];
                            if (u >= HALF_U) break;
                            dil_unit(p, lds, l, u);
                        }
                    } else
                    for (int u = u0 + c; u < u0 + HALF_U; u += G) dil_unit(p, lds, l, u);
                } else if (st == 3) {
                    constexpr int NU = NB * 256;
                    for (int u = c; u < NU / 2; u += G) { nsa_unit(p, lds, l, NU - 1 - u); nsa_unit(p, lds, l, u); }
#ifdef PROBE_NSA2
                    for (int u = c; u < NU / 2; u += G) { nsa_unit(p, lds, l, NU - 1 - u); nsa_unit(p, lds, l, u); }
#endif
                } else if (st == 4) {
                    { Gemm g{(const bf16_t*)(ws + O_OUTA), (const bf16_t*)(ws + O_WPA + l * 2 * SZ_WP), MT, DM, 1024, 1024};
                      StaticOrder so; so.init(MT, DM, G, c); EpiProjF e{(bf16_t*)(ws + O_MIXED), (const bf16_t*)(ws + O_MG)};
                      pg8::gemm_phase<EpiProjF, StaticOrder, true, true>(lds, g, so, e); }
                } else if (st == 5) {
                    Gemm g{(const bf16_t*)(ws + O_MIXED), (const bf16_t*)(ws + O_WOUT + l * SZ_WOUT), MT, DM, DM, DM};
                    StaticOrder so; so.init(MT, DM, G, c);
                    EpiRes e{nullptr, (bf16_t*)(ws + O_XB), (float*)(ws + O_RS2)};
                    pg8::gemm_phase<EpiRes, StaticOrder, true, true>(lds, g, so, e);
                } else if (st == 6) {
                    Gemm g{(const bf16_t*)(ws + O_XB), (const bf16_t*)(ws + O_WUP + l * SZ_WUP), MT, NUP, DM, DM};
                    StaticOrder so; so.init(MT, NUP, G, c);
                    EpiUpConv e{(bf16_t*)(ws + O_ACT), (const float*)(ws + O_RS2), p.conv_w + (size_t)l * 3 * DFF, p.conv_b + (size_t)l * DFF, (float*)(ws + O_GH), (float*)(ws + O_G0), (float*)(ws + O_U0)};
                    pg8::gemm_phase<EpiUpConv, StaticOrder, true, true>(lds, g, so, e);
                } else if (st == 7) {
                    phase_conv(p, l);
                } else {
                    Gemm g{(const bf16_t*)(ws + O_ACT), (const bf16_t*)(ws + O_WDN + l * SZ_WDN), MT, DM, DFF, DFF};
                    StaticOrder so; so.init(MT, DM, G, c);
                    EpiRes e{l == DEPTH - 1 ? xout : nullptr, (bf16_t*)(ws + O_XB), (float*)(ws + O_RS1)};
                    pg8::gemm_phase<EpiRes, StaticOrder, true, true>(lds, g, so, e);
                }
            }
        }
        if (ph + 1 < p.ph_hi) { xcd_barrier(xbar); if (ph == 0) grid.sync(); }
    }
}

extern "C" void kernel_launch(void* const* d_in, const int* in_sizes, int n_in, void* d_out, int out_size, void* d_ws, size_t ws_size, hipStream_t stream) {
    static int grid = 0;
    if (grid == 0) {
        if (ws_size < WS_NEED) { fprintf(stderr, "kernel_launch: workspace too small: %zu < %zu\n", ws_size, (size_t)WS_NEED); grid = -1; return; }
        int dev = 0, cus = 0, per_cu = 0;
        (void)hipGetDevice(&dev); (void)hipDeviceGetAttribute(&cus, hipDeviceAttributeMultiprocessorCount, dev);
        if (hipFuncSetAttribute((const void*)mega_fwd, hipFuncAttributeMaxDynamicSharedMemorySize, LDS_BYTES) != hipSuccess) { fprintf(stderr, "hipFuncSetAttribute failed\n"); grid = -1; return; }
        (void)hipOccupancyMaxActiveBlocksPerMultiprocessor(&per_cu, (const void*)mega_fwd, NTHREADS, LDS_BYTES);
        (void)hipGetLastError();
        if (per_cu < 1) per_cu = 1;
        grid = cus;
    }
    if (grid < 0) return;
    (void)hipMemsetAsync(d_ws, 0, 16384, stream);
    Params p{};
    const float** pp = (const float**)&p;
    for (int i = 0; i < 18; ++i) pp[i] = (const float*)d_in[i];
    p.out = (float*)d_out; p.ws = (unsigned char*)d_ws;
#ifdef MULTI_LAUNCH
    for (int ph = 0; ph < NPHASES; ++ph) { p.ph_lo = ph; p.ph_hi = ph + 1; hipLaunchKernelGGL(mega_fwd, dim3(grid), dim3(NTHREADS), LDS_BYTES, stream, p); }
#else
    p.ph_lo = 0; p.ph_hi = NPHASES;
    void* args[] = {&p};
    hipError_t e = hipLaunchCooperativeKernel((const void*)mega_fwd, dim3(grid), dim3(NTHREADS), args, LDS_BYTES, stream);
    if (e != hipSuccess) fprintf(stderr, "cooperative launch failed: %s (grid %d)\n", hipGetErrorString(e), grid);
#endif
}
```
